# Optimizing an MI355X kernel written in HIP

```python
import math
import jax, jax.numpy as jnp
from jax import lax
import numpy as np

D_MODEL = 1024
BATCH = 2
SEQ = 16384
DEPTH = 1

N_HEADS = 8
HEAD_DIM = D_MODEL // N_HEADS
ATTN_WIDTH = N_HEADS * HEAD_DIM
CONV_WIDTH = D_MODEL
CONV_KERNEL = 31
MOBA_BLOCK = 256
MOBA_TOPK = 3
Q_CHUNK = 64
D_FF = -(-8 * D_MODEL // (3 * 256)) * 256
EPS = 1e-6
IN_SPLITS = (CONV_WIDTH, CONV_WIDTH, ATTN_WIDTH, ATTN_WIDTH, ATTN_WIDTH, D_MODEL, D_MODEL)
IN_WIDTH = sum(IN_SPLITS)

kernel_name = 'hybrid_conformer_conv_moba_swiglu'


def rmsnorm(x, g):
    xf = x.astype(jnp.float32)
    y = xf * lax.rsqrt(jnp.mean(xf * xf, axis=-1, keepdims=True) + EPS)
    return (y * g.astype(jnp.float32)).astype(x.dtype)


def layernorm(x, g, b):
    xf = x.astype(jnp.float32)
    mu = jnp.mean(xf, axis=-1, keepdims=True)
    xc = xf - mu
    y = xc * lax.rsqrt(jnp.mean(xc * xc, axis=-1, keepdims=True) + EPS)
    return (y * g.astype(jnp.float32) + b.astype(jnp.float32)).astype(x.dtype)


def alibi_slopes(n_heads):
    return jnp.exp2(-8.0 * jnp.arange(1, n_heads + 1, dtype=jnp.float32) / n_heads)


def conformer_conv(u, gate, dw_w, dw_b, ln_g, ln_b, w_pw2):
    a = u * jax.nn.sigmoid(gate)
    c = a.shape[-1]
    y = lax.conv_general_dilated(
        a, dw_w.astype(a.dtype)[:, None, :], window_strides=(1,),
        padding=[(CONV_KERNEL - 1, 0)], dimension_numbers=('NWC', 'WIO', 'NWC'),
        feature_group_count=c) + dw_b
    y = jax.nn.silu(layernorm(y, ln_g, ln_b))
    return y @ w_pw2


def moba_attention(q, k, v, qn_g, kn_g):
    B, S, H, Dh = q.shape
    L = MOBA_BLOCK
    nb = S // L
    nc = S // Q_CHUNK
    ksel = min(MOBA_TOPK, nb)
    q = rmsnorm(q, qn_g).transpose(0, 2, 1, 3)
    k = rmsnorm(k, kn_g).transpose(0, 2, 1, 3)
    v = v.transpose(0, 2, 1, 3)
    kb = k.reshape(B, H, nb, L, Dh)
    vb = v.reshape(B, H, nb, L, Dh)
    kmean = jnp.mean(kb.astype(jnp.float32), axis=3)
    slopes = alibi_slopes(H)
    sl4 = slopes.reshape(1, H, 1, 1)
    sl5 = slopes.reshape(1, H, 1, 1, 1)
    scale = Dh ** -0.5
    bi = jnp.arange(B)[:, None, None, None]
    hi = jnp.arange(H)[None, :, None, None]
    blk_ids = jnp.arange(nb)
    offs = jnp.arange(L)
    q_chunks = q.reshape(B, H, nc, Q_CHUNK, Dh).transpose(2, 0, 1, 3, 4)

    def chunk(args):
        ci, qc = args
        t = ci * Q_CHUNK + jnp.arange(Q_CHUNK)
        cur = (ci * Q_CHUNK) // L
        gate = jnp.einsum('bhqd,bhnd->bhqn', qc.astype(jnp.float32), kmean)
        gate = jnp.where(blk_ids < cur, gate, -jnp.inf)
        _, idx = lax.top_k(gate, ksel)
        sel_ok = idx < cur
        k_sel = kb[bi, hi, idx]
        v_sel = vb[bi, hi, idx]
        s_past = jnp.einsum('bhqd,bhqkld->bhqkl', qc, k_sel).astype(jnp.float32) * scale
        pos_past = idx[..., None] * L + offs
        dist_past = (t[:, None, None] - pos_past).astype(jnp.float32)
        s_past = jnp.where(sel_ok[..., None], s_past - sl5 * dist_past, -jnp.inf)
        s_past = s_past.reshape(B, H, Q_CHUNK, ksel * L)
        k_own = lax.dynamic_index_in_dim(kb, cur, axis=2, keepdims=False)
        v_own = lax.dynamic_index_in_dim(vb, cur, axis=2, keepdims=False)
        s_own = jnp.einsum('bhqd,bhld->bhql', qc, k_own).astype(jnp.float32) * scale
        dist_own = t[:, None] - (cur * L + offs)[None, :]
        s_own = jnp.where(dist_own >= 0, s_own - sl4 * dist_own.astype(jnp.float32), -jnp.inf)
        p = jax.nn.softmax(jnp.concatenate([s_past, s_own], axis=-1), axis=-1)
        p_past = p[..., :ksel * L].reshape(B, H, Q_CHUNK, ksel, L).astype(v.dtype)
        p_own = p[..., ksel * L:].astype(v.dtype)
        return (jnp.einsum('bhqkl,bhqkld->bhqd', p_past, v_sel)
                + jnp.einsum('bhql,bhld->bhqd', p_own, v_own))

    o = lax.map(chunk, (jnp.arange(nc), q_chunks))
    return o.transpose(1, 0, 3, 2, 4).reshape(B, S, H * Dh)


def swiglu(x, w_gate, w_up, w_down):
    return (jax.nn.silu(x @ w_gate) * (x @ w_up)) @ w_down


def setup_inputs(seed: int = 0) -> dict:
    key = jax.random.key(seed)
    ks = jax.random.split(key, 20)
    f32 = jnp.float32

    def nrm(k, shape, fan_in):
        return jax.random.normal(k, shape, f32) * (fan_in ** -0.5)

    def gain(k, shape):
        return 1.0 + 0.01 * jax.random.normal(k, shape, f32)

    def bias(k, shape):
        return 0.01 * jax.random.normal(k, shape, f32)

    return {
        'x': jax.random.normal(ks[0], (BATCH, SEQ, D_MODEL), f32),
        'norm1_g': gain(ks[1], (DEPTH, D_MODEL)),
        'w_in': nrm(ks[2], (DEPTH, D_MODEL, IN_WIDTH), D_MODEL),
        'dw_w': nrm(ks[3], (DEPTH, CONV_KERNEL, CONV_WIDTH), CONV_KERNEL),
        'dw_b': bias(ks[4], (DEPTH, CONV_WIDTH)),
        'conv_ln_g': gain(ks[5], (DEPTH, CONV_WIDTH)),
        'conv_ln_b': bias(ks[6], (DEPTH, CONV_WIDTH)),
        'w_conv_out': nrm(ks[7], (DEPTH, CONV_WIDTH, D_MODEL), CONV_WIDTH),
        'q_norm_g': gain(ks[8], (DEPTH, HEAD_DIM)),
        'k_norm_g': gain(ks[9], (DEPTH, HEAD_DIM)),
        'w_attn_out': nrm(ks[10], (DEPTH, ATTN_WIDTH, D_MODEL), ATTN_WIDTH),
        'w_out': nrm(ks[11], (DEPTH, D_MODEL, D_MODEL), D_MODEL),
        'norm2_g': gain(ks[12], (DEPTH, D_MODEL)),
        'w_ffn_gate': nrm(ks[13], (DEPTH, D_MODEL, D_FF), D_MODEL),
        'w_ffn_up': nrm(ks[14], (DEPTH, D_MODEL, D_FF), D_MODEL),
        'w_ffn_down': nrm(ks[15], (DEPTH, D_FF, D_MODEL), D_FF),
    }


def reference(x, norm1_g, w_in, dw_w, dw_b, conv_ln_g, conv_ln_b, w_conv_out,
              q_norm_g, k_norm_g, w_attn_out, w_out, norm2_g,
              w_ffn_gate, w_ffn_up, w_ffn_down):
    B, S, _ = x.shape
    cuts = [int(c) for c in np.cumsum(IN_SPLITS)[:-1]]
    h = x
    for l in range(DEPTH):
        n = rmsnorm(h, norm1_g[l])
        z = n @ w_in[l]
        cu, cg, q, k, v, gc, ga = jnp.split(z, cuts, axis=-1)
        y_conv = conformer_conv(cu, cg, dw_w[l], dw_b[l], conv_ln_g[l], conv_ln_b[l], w_conv_out[l])
        att = moba_attention(q.reshape(B, S, N_HEADS, HEAD_DIM),
                             k.reshape(B, S, N_HEADS, HEAD_DIM),
                             v.reshape(B, S, N_HEADS, HEAD_DIM),
                             q_norm_g[l], k_norm_g[l])
        y_attn = att @ w_attn_out[l]
        merged = jax.nn.sigmoid(gc) * y_conv + jax.nn.sigmoid(ga) * y_attn
        h = h + merged @ w_out[l]
        h = h + swiglu(rmsnorm(h, norm2_g[l]), w_ffn_gate[l], w_ffn_up[l], w_ffn_down[l])
    return h
```

```cpp
#include <hip/hip_runtime.h>
#include <cstdio>
#include <cstdint>
namespace pg8 {
#define PG8_LAS __attribute__((address_space(3)))
typedef unsigned short bf16_t;
typedef short bf16x8 __attribute__((ext_vector_type(8)));
typedef float f32x4 __attribute__((ext_vector_type(4)));
typedef unsigned u32x4 __attribute__((ext_vector_type(4)));
constexpr int BM = 256, BK = 64, HALF = 128, HTB = HALF * BK * 2  , STAGE_BYTES = 8 * HTB, NXCD = 8, WGM = 8;

__host__ __device__ __forceinline__ int lds_byte(int r, int c) { const int st = (r >> 4) * 2 + (c >> 5), rr = r & 15, cc = c & 31, ob = rr * 64 + cc * 2; return st * 1024 + (ob ^ (((ob >> 9) & 1) << 5)); }
__host__ __device__ __forceinline__ void stage_rc(int b, int& R, int& C) { const int st = b / 1024, sb = b % 1024, swz = sb ^ (((sb >> 9) & 1) << 5); R = (st >> 1) * 16 + swz / 64; C = (st & 1) * 32 + (swz % 64) / 2; }
__host__ __device__ __forceinline__ int perm32(int rho) { const int n = rho >> 4, i = rho & 15; return 8 * (i >> 2) + 4 * n + (i & 3); }

struct Unit { int pm, pn; };
struct Gemm { const bf16_t* A; const bf16_t* Bt; int M, N, K; };

struct StaticOrder {
    int nM, nN, nwg, G, c;
    __host__ __device__ void init(int M, int N, int G_, int c_) { nM = M / BM; nN = N / BM; nwg = nM * nN; G = G_; c = c_; }
    __host__ __device__ bool next(int i, Unit& u) const {
        const long L = (long)i * G + c; if (L >= nwg) return false;
        int wgid = (int)L; { const int q = nwg / NXCD, r = nwg % NXCD, xcd = wgid % NXCD, off = wgid / NXCD; wgid = (xcd < r ? xcd * (q + 1) : r * (q + 1) + (xcd - r) * q) + off; }
        const int nig = WGM * nN, gid = wgid / nig, fm = gid * WGM, gsz = (nM - fm) < WGM ? (nM - fm) : WGM;
        u.pm = fm + ((wgid % nig) % gsz); u.pn = (wgid % nig) / gsz; return true;
    }
    __device__ __forceinline__ void a_ready(const Unit&) const {}
    __device__ __forceinline__ void done(const Unit&) const {}
};

__device__ __forceinline__ unsigned cvt_pk_bf16(float lo, float hi) { unsigned r; asm volatile("v_cvt_pk_bf16_f32 %0, %1, %2" : "=v"(r) : "v"(lo), "v"(hi)); return r; }
__device__ __forceinline__ u32x4 pack8(const f32x4 a, const f32x4 b) { u32x4 w; w.x = cvt_pk_bf16(a[0], a[1]); w.y = cvt_pk_bf16(a[2], a[3]); w.z = cvt_pk_bf16(b[0], b[1]); w.w = cvt_pk_bf16(b[2], b[3]); return w; }
__device__ __forceinline__ void unpack8(const u32x4 w, f32x4& a, f32x4& b) {
    a[0] = __uint_as_float(w.x << 16); a[1] = __uint_as_float(w.x & 0xffff0000u); a[2] = __uint_as_float(w.y << 16); a[3] = __uint_as_float(w.y & 0xffff0000u);
    b[0] = __uint_as_float(w.z << 16); b[1] = __uint_as_float(w.z & 0xffff0000u); b[2] = __uint_as_float(w.w << 16); b[3] = __uint_as_float(w.w & 0xffff0000u); }
__device__ __forceinline__ float sigm(float x) { return __builtin_amdgcn_rcpf(1.f + __builtin_amdgcn_exp2f(-1.4426950408889634f * x)); }
__device__ __forceinline__ f32x4 sigm4(const f32x4 x) { f32x4 r; r[0] = sigm(x[0]); r[1] = sigm(x[1]); r[2] = sigm(x[2]); r[3] = sigm(x[3]); return r; }
__device__ __forceinline__ float dot4(const f32x4 a) { return (a[0] * a[0] + a[1] * a[1]) + (a[2] * a[2] + a[3] * a[3]); }
#define PG8_EPI_BAR() do { asm volatile("s_waitcnt lgkmcnt(0)" ::: "memory"); __builtin_amdgcn_s_barrier(); asm volatile("" ::: "memory"); } while (0)

constexpr float QSCALE = 0.08838834764831845f * 1.4426950408889634f;
constexpr float NORM_EPS = 1e-6f;

struct EpiInProj {
    static constexpr bool PERM = true, AFTER_DRAIN = false;
    bf16_t *a, *q, *v; float* kpart; const float *gq, *gk;
    __device__ __forceinline__ void operator()(const f32x4 (&acc)[2][2][4][2], const Unit& u, int wr, int wc, int fr, int fq, PG8_LAS float* X, int wid, int lane) const {
        asm volatile("" : "+v"(fr), "+v"(fq));
        const int pn = u.pn, row0 = u.pm * BM + wr * 64 + fr, cw = wc * 32 + 8 * fq;
        if (pn < 8) {
#pragma unroll
            for (int ai = 0; ai < 2; ++ai)
#pragma unroll
                for (int m = 0; m < 4; ++m) {
                    const f32x4 o0 = acc[ai][0][m][0] * sigm4(acc[ai][1][m][0]), o1 = acc[ai][0][m][1] * sigm4(acc[ai][1][m][1]);
                    *(u32x4*)(a + (size_t)(row0 + ai * HALF + m * 16) * 1024 + pn * 128 + cw) = pack8(o0, o1); asm volatile("" ::: "memory"); }
        } else if (pn < 16) {
            const bool isk = pn >= 12; const int hd0 = ((pn - 8) & 3) * 2;
            const float* gv = isk ? gk : gq; bf16_t* dst = q + (isk ? ((size_t)32 << 20) : (size_t)0);
            f32x4 g0 = *(const f32x4*)(gv + cw), g1 = *(const f32x4*)(gv + cw + 4);
            if (!isk) { g0 = g0 * QSCALE; g1 = g1 * QSCALE; }
            PG8_LAS float* P = X + wr * 1024;
#pragma unroll
            for (int ai = 0; ai < 2; ++ai)
#pragma unroll
                for (int m = 0; m < 4; ++m)
#pragma unroll
                    for (int bj = 0; bj < 2; ++bj) { float s = dot4(acc[ai][bj][m][0]) + dot4(acc[ai][bj][m][1]); s += __shfl_xor(s, 16); s += __shfl_xor(s, 32);
                        if (fq == 0) P[((ai * 64 + m * 16 + fr) * 2 + bj) * 4 + wc] = s; }
            PG8_EPI_BAR();
#pragma unroll
            for (int bj = 0; bj < 2; ++bj) {
                f32x4 c0 = (f32x4){0.f, 0.f, 0.f, 0.f}, c1 = (f32x4){0.f, 0.f, 0.f, 0.f};
#pragma unroll
                for (int ai = 0; ai < 2; ++ai)
#pragma unroll
                    for (int m = 0; m < 4; ++m) { const f32x4 p = *(const PG8_LAS f32x4*)(P + ((ai * 64 + m * 16 + fr) * 2 + bj) * 4);
                        const float r = __builtin_amdgcn_rsqf(((p[0] + p[1]) + (p[2] + p[3])) * (1.0f / 128.0f) + NORM_EPS);
                        const f32x4 y0 = acc[ai][bj][m][0] * r, y1 = acc[ai][bj][m][1] * r;
                        c0 += y0; c1 += y1;
                        *(u32x4*)(dst + (size_t)(row0 + ai * HALF + m * 16) * 1024 + (hd0 + bj) * 128 + cw) = pack8(y0 * g0, y1 * g1); asm volatile("" ::: "memory"); }
                if (isk) {
                    c0 = c0 * g0; c1 = c1 * g1;
#pragma unroll
                    for (int e = 0; e < 4; ++e) { float s = c0[e]; s += __shfl_xor(s, 1); s += __shfl_xor(s, 2); s += __shfl_xor(s, 4); s += __shfl_xor(s, 8); c0[e] = s;
                        float t = c1[e]; t += __shfl_xor(t, 1); t += __shfl_xor(t, 2); t += __shfl_xor(t, 4); t += __shfl_xor(t, 8); c1[e] = t; }
                    if (fr == 0) { const int b = u.pm >> 6, blk = u.pm & 63; float* kp = kpart + ((size_t)(((b * 8 + hd0 + bj) * 64 + blk) * 2 + wr)) * 128 + cw;
                        *(f32x4*)kp = c0; *(f32x4*)(kp + 4) = c1; }
                }
            }
        } else {
            const int t = (pn - 16) >> 2, cb = ((pn - 16) & 3) * 256;
            bf16_t* dst = v + (size_t)t * ((size_t)32 << 20);
#pragma unroll
            for (int ai = 0; ai < 2; ++ai)
#pragma unroll
                for (int m = 0; m < 4; ++m)
#pragma unroll
                    for (int bj = 0; bj < 2; ++bj) { f32x4 x0 = acc[ai][bj][m][0], x1 = acc[ai][bj][m][1];
                        if (t) { x0 = sigm4(x0); x1 = sigm4(x1); }
                        *(u32x4*)(dst + (size_t)(row0 + ai * HALF + m * 16) * 1024 + cb + bj * HALF + cw) = pack8(x0, x1); asm volatile("" ::: "memory"); }
        }
    }
};
struct EpiGateMul {
    static constexpr bool PERM = true, AFTER_DRAIN = false;
    bf16_t* T;
    __device__ __forceinline__ void operator()(const f32x4 (&acc)[2][2][4][2], const Unit& u, int wr, int wc, int fr, int fq, PG8_LAS float*, int, int) const {
        asm volatile("" : "+v"(fr), "+v"(fq));
        const int row0 = u.pm * BM + wr * 64 + fr, col0 = u.pn * BM + wc * 32 + 8 * fq;
#pragma unroll
        for (int ai = 0; ai < 2; ++ai)
#pragma unroll
            for (int m = 0; m < 4; ++m)
#pragma unroll
                for (int bj = 0; bj < 2; ++bj) { bf16_t* p = T + (size_t)(row0 + ai * HALF + m * 16) * 1024 + col0 + bj * HALF;
                    f32x4 s0, s1; unpack8(*(const u32x4*)p, s0, s1);
                    *(u32x4*)p = pack8(s0 * acc[ai][bj][m][0], s1 * acc[ai][bj][m][1]); asm volatile("" ::: "memory"); }
    }
};
struct EpiMerge {
    static constexpr bool PERM = true, AFTER_DRAIN = false;
    const bf16_t *T1, *SG; bf16_t* O;
    __device__ __forceinline__ void operator()(const f32x4 (&acc)[2][2][4][2], const Unit& u, int wr, int wc, int fr, int fq, PG8_LAS float*, int, int) const {
        asm volatile("" : "+v"(fr), "+v"(fq));
        const int row0 = u.pm * BM + wr * 64 + fr, col0 = u.pn * BM + wc * 32 + 8 * fq;
#pragma unroll
        for (int ai = 0; ai < 2; ++ai)
#pragma unroll
            for (int m = 0; m < 4; ++m)
#pragma unroll
                for (int bj = 0; bj < 2; ++bj) { const size_t off = (size_t)(row0 + ai * HALF + m * 16) * 1024 + col0 + bj * HALF;
                    f32x4 t0, t1, s0, s1; unpack8(*(const u32x4*)(T1 + off), t0, t1); unpack8(*(const u32x4*)(SG + off), s0, s1);
                    *(u32x4*)(O + off) = pack8(t0 + s0 * acc[ai][bj][m][0], t1 + s1 * acc[ai][bj][m][1]); asm volatile("" ::: "memory"); }
    }
};
struct EpiResNorm {
    static constexpr bool PERM = true, AFTER_DRAIN = false;
    const float* x; float* out; bf16_t* hg; const float* g2; float* ssq4;
    __device__ __forceinline__ void operator()(const f32x4 (&acc)[2][2][4][2], const Unit& u, int wr, int wc, int fr, int fq, PG8_LAS float* X, int wid, int lane) const {
        asm volatile("" : "+v"(fr), "+v"(fq));
        const int row0 = u.pm * BM + wr * 64 + fr, col0 = u.pn * BM + wc * 32 + 8 * fq;
        PG8_LAS float* P = X + wr * 1024;
        f32x4 gg[2][2];
#pragma unroll
        for (int bj = 0; bj < 2; ++bj) { gg[bj][0] = *(const f32x4*)(g2 + col0 + bj * HALF); gg[bj][1] = *(const f32x4*)(g2 + col0 + bj * HALF + 4); }
#pragma unroll
        for (int ai = 0; ai < 2; ++ai)
#pragma unroll
            for (int m = 0; m < 4; ++m) { float s = 0.f;
#pragma unroll
                for (int bj = 0; bj < 2; ++bj) { const size_t off = (size_t)(row0 + ai * HALF + m * 16) * 1024 + col0 + bj * HALF;
                    const f32x4 h0 = *(const f32x4*)(x + off) + acc[ai][bj][m][0], h1 = *(const f32x4*)(x + off + 4) + acc[ai][bj][m][1];
                    *(f32x4*)(out + off) = h0; *(f32x4*)(out + off + 4) = h1; s += dot4(h0) + dot4(h1);
                    *(u32x4*)(hg + off) = pack8(h0 * gg[bj][0], h1 * gg[bj][1]); asm volatile("" ::: "memory"); }
                s += __shfl_xor(s, 16); s += __shfl_xor(s, 32);
                if (fq == 0) P[(ai * 64 + m * 16 + fr) * 4 + wc] = s; }
        PG8_EPI_BAR();
        if (wc == 0) {
#pragma unroll
            for (int i = 0; i < 2; ++i) { const int rr = lane + 64 * i; const f32x4 p = *(const PG8_LAS f32x4*)(P + rr * 4);
                const int ai = rr >> 6, rem = rr & 63;
                ssq4[(size_t)(u.pm * BM + ai * HALF + wr * 64 + rem) * 4 + u.pn] = (p[0] + p[1]) + (p[2] + p[3]); }
        }
    }
};
struct EpiSwiGLU {
    static constexpr bool PERM = true, AFTER_DRAIN = false;
    const float* ssq4; bf16_t* act; int ldc;
    __device__ __forceinline__ void operator()(const f32x4 (&acc)[2][2][4][2], const Unit& u, int wr, int wc, int fr, int fq, PG8_LAS float*, int, int) const {
        asm volatile("" : "+v"(fr), "+v"(fq));
        const int row0 = u.pm * BM + wr * 64 + fr, col0 = u.pn * HALF + wc * 32 + 8 * fq;
#pragma unroll
        for (int ai = 0; ai < 2; ++ai)
#pragma unroll
            for (int m = 0; m < 4; ++m) { const int row = row0 + ai * HALF + m * 16; const f32x4 p = *(const f32x4*)(ssq4 + (size_t)row * 4);
                const float r = __builtin_amdgcn_rsqf(((p[0] + p[1]) + (p[2] + p[3])) * (1.0f / 1024.0f) + NORM_EPS);
                const f32x4 g0 = acc[ai][0][m][0] * r, g1 = acc[ai][0][m][1] * r, u0 = acc[ai][1][m][0] * r, u1 = acc[ai][1][m][1] * r;
                *(u32x4*)(act + (size_t)row * ldc + col0) = pack8(g0 * sigm4(g0) * u0, g1 * sigm4(g1) * u1); asm volatile("" ::: "memory"); }
    }
};
struct EpiResOut {
    static constexpr bool PERM = true, AFTER_DRAIN = false;
    float* out;
    __device__ __forceinline__ void operator()(const f32x4 (&acc)[2][2][4][2], const Unit& u, int wr, int wc, int fr, int fq, PG8_LAS float*, int, int) const {
        asm volatile("" : "+v"(fr), "+v"(fq));
        const int row0 = u.pm * BM + wr * 64 + fr, col0 = u.pn * BM + wc * 32 + 8 * fq;
#pragma unroll
        for (int ai = 0; ai < 2; ++ai)
#pragma unroll
            for (int m = 0; m < 4; ++m)
#pragma unroll
                for (int bj = 0; bj < 2; ++bj) { float* p = out + (size_t)(row0 + ai * HALF + m * 16) * 1024 + col0 + bj * HALF;
                    const f32x4 h0 = *(const f32x4*)p + acc[ai][bj][m][0], h1 = *(const f32x4*)(p + 4) + acc[ai][bj][m][1];
                    *(f32x4*)p = h0; *(f32x4*)(p + 4) = h1; asm volatile("" ::: "memory"); }
    }
};
template <class Epi, class Sched, bool ALIGN_EPI = false, bool SP2 = false>
__device__ __forceinline__ void gemm_phase(PG8_LAS unsigned char* lds, PG8_LAS float* epx, const Gemm g, const Sched& S, const Epi& E) {
    const int tid = threadIdx.x, wid = __builtin_amdgcn_readfirstlane(tid >> 6), lane = tid & 63, wr = wid >> 2, wc = wid & 3, fr = lane & 15, fq = lane >> 4;
    const int K = g.K, nt = K / BK;
    unsigned voffA[2], voffB[2];
#pragma unroll
    for (int i = 0; i < 2; ++i) { int R, C; stage_rc(tid * 16 + i * 8192, R, C); const int Rb = Epi::PERM ? ((R & ~31) + perm32(R & 31)) : R;
        voffA[i] = (unsigned)(R * K + C) * 2u; voffB[i] = (unsigned)(Rb * K + C) * 2u; }
    const size_t kstep = (size_t)(BK * 2);
    const size_t hstep = (size_t)HALF * K * 2;
    const size_t tstep = 2 * hstep;
    const unsigned ldsw = (unsigned)wid * 1024u;
    const int aoff = lds_byte(wr * 64 + fr, fq * 8), boff = lds_byte(wc * 32 + fr, fq * 8);
#define PG8_SA(b, h) (((b) * 2 + (h)) * HTB)
#define PG8_SB(b, h) ((4 + (b) * 2 + (h)) * HTB)
#define PG8_STAGE(bufoff, gbase, voff) do { _Pragma("unroll") for (int _i = 0; _i < 2; ++_i) \
        __builtin_amdgcn_global_load_lds((const unsigned*)((const char*)(gbase) + (voff)[_i]), (PG8_LAS unsigned*)(lds + (bufoff) + ldsw + _i * 8192), 16, 0, 0); } while (0)
#define PG8_LDA(dst, b, h) do { _Pragma("unroll") for (int m = 0; m < 4; ++m) _Pragma("unroll") for (int k = 0; k < 2; ++k) dst[m][k] = *(const PG8_LAS bf16x8*)(lds + PG8_SA(b, h) + aoff + m * 2048 + k * 1024); } while (0)
#define PG8_LDB(dst, b, h) do { _Pragma("unroll") for (int n = 0; n < 2; ++n) _Pragma("unroll") for (int k = 0; k < 2; ++k) dst[n][k] = *(const PG8_LAS bf16x8*)(lds + PG8_SB(b, h) + boff + n * 2048 + k * 1024); } while (0)
#define PG8_MMA(ai, bj, At, Bt) do { __builtin_amdgcn_s_setprio(1); _Pragma("unroll") for (int m = 0; m < 4; ++m) _Pragma("unroll") for (int n = 0; n < 2; ++n) _Pragma("unroll") for (int k = 0; k < 2; ++k) \
        acc[ai][bj][m][n] = __builtin_amdgcn_mfma_f32_16x16x32_bf16(Bt[n][k], At[m][k], acc[ai][bj][m][n], 0, 0, 0); __builtin_amdgcn_s_setprio(0); } while (0)
#define PG8_WAIT_V(n) asm volatile("s_waitcnt vmcnt(" #n ")" ::: "memory")
#define PG8_WAIT_L(n) asm volatile("s_waitcnt lgkmcnt(" #n ")" ::: "memory")
#define PG8_BAR __builtin_amdgcn_s_barrier()
#define PG8_SCHED __builtin_amdgcn_sched_barrier(0)
    Unit cur, nxt; int ui = 0;
    if (!S.next(0, cur)) return;
    f32x4 acc[2][2][4][2];
#pragma unroll
    for (int a = 0; a < 2; ++a)
#pragma unroll
        for (int b = 0; b < 2; ++b)
#pragma unroll
            for (int m = 0; m < 4; ++m)
#pragma unroll
                for (int n = 0; n < 2; ++n) acc[a][b][m][n] = (f32x4){0.f, 0.f, 0.f, 0.f};
    bf16x8 At[4][2], B0[2][2], B1[2][2];
    const char* cA = (const char*)g.A + (size_t)cur.pm * tstep; const char* cB = (const char*)g.Bt + (size_t)cur.pn * tstep;
    S.a_ready(cur);
    if constexpr (SP2) {
        PG8_STAGE(PG8_SB(0, 0), cB, voffB); PG8_STAGE(PG8_SB(0, 1), cB + hstep, voffB); PG8_STAGE(PG8_SA(0, 0), cA, voffA); PG8_STAGE(PG8_SA(0, 1), cA + hstep, voffA);
        if (wr == 1) PG8_BAR;
        PG8_WAIT_V(2); PG8_BAR;
        PG8_STAGE(PG8_SB(1, 0), cB + kstep, voffB); PG8_STAGE(PG8_SA(1, 0), cA + kstep, voffA); PG8_STAGE(PG8_SB(1, 1), cB + hstep + kstep, voffB);
        PG8_WAIT_V(6); PG8_BAR;
    } else {
        PG8_STAGE(PG8_SB(0, 0), cB, voffB); PG8_STAGE(PG8_SA(0, 0), cA, voffA); PG8_STAGE(PG8_SB(0, 1), cB + hstep, voffB); PG8_STAGE(PG8_SA(0, 1), cA + hstep, voffA);
        if (wr == 1) PG8_BAR;
        PG8_WAIT_V(4); PG8_BAR;
        PG8_STAGE(PG8_SB(1, 0), cB + kstep, voffB); PG8_STAGE(PG8_SA(1, 0), cA + kstep, voffA); PG8_STAGE(PG8_SB(1, 1), cB + hstep + kstep, voffB);
        PG8_WAIT_V(6); PG8_BAR;
    }
    for (;;) {
        const bool has_next = S.next(ui + 1, nxt);
        const char* nA = has_next ? (const char*)g.A + (size_t)nxt.pm * tstep : cA; const char* nB = has_next ? (const char*)g.Bt + (size_t)nxt.pn * tstep : cB;
        for (int t = 0; t < nt; t += 2) {
            const bool last = (t == nt - 2);
            const char* a1 = cA + (size_t)(t + 1) * kstep;
            const char* a2 = last ? nA : cA + (size_t)(t + 2) * kstep; const char* b2 = last ? nB : cB + (size_t)(t + 2) * kstep;
            const char* a3 = a2 + kstep; const char* b3 = b2 + kstep;
            if (last && has_next) S.a_ready(nxt);
            if constexpr (SP2) {
            PG8_LDB(B0, 0, 0); PG8_LDB(B1, 0, 1); PG8_SCHED; PG8_LDA(At, 0, 0); PG8_STAGE(PG8_SA(1, 1), a1 + hstep, voffA);
            PG8_WAIT_V(8); PG8_WAIT_L(0); PG8_BAR; PG8_MMA(0, 0, At, B0); PG8_MMA(0, 1, At, B1); PG8_BAR; PG8_SCHED;
            PG8_LDA(At, 0, 1); PG8_STAGE(PG8_SB(0, 0), b2, voffB); PG8_STAGE(PG8_SB(0, 1), b2 + hstep, voffB); PG8_STAGE(PG8_SA(0, 0), a2, voffA);
            PG8_WAIT_V(8); PG8_WAIT_L(0); PG8_BAR; PG8_MMA(1, 0, At, B0); PG8_MMA(1, 1, At, B1); PG8_BAR; PG8_SCHED;
            PG8_LDB(B0, 1, 0); PG8_LDB(B1, 1, 1); PG8_SCHED; PG8_LDA(At, 1, 0); PG8_STAGE(PG8_SA(0, 1), a2 + hstep, voffA);
            PG8_WAIT_V(8); PG8_WAIT_L(0); PG8_BAR; PG8_MMA(0, 0, At, B0); PG8_MMA(0, 1, At, B1); PG8_BAR; PG8_SCHED;
            PG8_LDA(At, 1, 1); PG8_STAGE(PG8_SB(1, 0), b3, voffB); PG8_STAGE(PG8_SB(1, 1), b3 + hstep, voffB); PG8_STAGE(PG8_SA(1, 0), a3, voffA);
            PG8_WAIT_V(8); PG8_WAIT_L(0); PG8_BAR; PG8_MMA(1, 0, At, B0); PG8_MMA(1, 1, At, B1); PG8_BAR; PG8_SCHED;
            } else {
            PG8_LDB(B0, 0, 0); PG8_SCHED; PG8_LDA(At, 0, 0); PG8_STAGE(PG8_SA(1, 1), a1 + hstep, voffA);
            PG8_WAIT_L(8); PG8_BAR; PG8_WAIT_L(0); PG8_MMA(0, 0, At, B0); PG8_BAR; PG8_SCHED;
            PG8_LDB(B1, 0, 1); PG8_STAGE(PG8_SB(0, 0), b2, voffB);
            PG8_BAR; PG8_WAIT_L(0); PG8_MMA(0, 1, At, B1); PG8_BAR;
            PG8_LDA(At, 0, 1); PG8_STAGE(PG8_SA(0, 0), a2, voffA);
            PG8_BAR; PG8_WAIT_L(0); PG8_MMA(1, 0, At, B0); PG8_BAR; PG8_SCHED;
            PG8_STAGE(PG8_SB(0, 1), b2 + hstep, voffB);
            PG8_WAIT_V(6); PG8_BAR; PG8_MMA(1, 1, At, B1); PG8_BAR;
            PG8_LDB(B0, 1, 0); PG8_SCHED; PG8_LDA(At, 1, 0); PG8_STAGE(PG8_SA(0, 1), a2 + hstep, voffA);
            PG8_WAIT_L(8); PG8_BAR; PG8_WAIT_L(0); PG8_MMA(0, 0, At, B0); PG8_BAR; PG8_SCHED;
            PG8_LDB(B1, 1, 1); PG8_STAGE(PG8_SB(1, 0), b3, voffB);
            PG8_BAR; PG8_WAIT_L(0); PG8_MMA(0, 1, At, B1); PG8_BAR;
            PG8_LDA(At, 1, 1); PG8_STAGE(PG8_SA(1, 0), a3, voffA);
            PG8_BAR; PG8_WAIT_L(0); PG8_MMA(1, 0, At, B0); PG8_BAR; PG8_SCHED;
            PG8_STAGE(PG8_SB(1, 1), b3 + hstep, voffB);
            PG8_WAIT_V(6); PG8_BAR; PG8_MMA(1, 1, At, B1); PG8_BAR;
            }
        }
        if constexpr (ALIGN_EPI) { if (wr == 0) PG8_BAR; }
        E(acc, cur, wr, wc, fr, fq, epx, wid, lane); S.done(cur);
        if (!has_next) break;
#pragma unroll
        for (int a = 0; a < 2; ++a)
#pragma unroll
            for (int b = 0; b < 2; ++b)
#pragma unroll
                for (int m = 0; m < 4; ++m)
#pragma unroll
                    for (int n = 0; n < 2; ++n) acc[a][b][m][n] = (f32x4){0.f, 0.f, 0.f, 0.f};
        cur = nxt; cA = nA; cB = nB; ++ui;
        if constexpr (ALIGN_EPI) { if (wr == 1) PG8_BAR; }
    }
    PG8_WAIT_V(0);
    if constexpr (!ALIGN_EPI) { if (wr == 0) PG8_BAR; }
    PG8_BAR;
#undef PG8_SA
#undef PG8_SB
#undef PG8_STAGE
#undef PG8_LDA
#undef PG8_LDB
#undef PG8_MMA
#undef PG8_WAIT_V
#undef PG8_WAIT_L
#undef PG8_BAR
#undef PG8_SCHED
}
}
constexpr int NWAVES = 8;
constexpr int BATCH = 2, SEQ = 16384, D = 1024, M = BATCH * SEQ, NH = 8, DH = 128, LBLK = 256, NB = SEQ / LBLK, TOPK = 3, DFF = 2816, NIN = 7168, CKW = 31;
constexpr float LN_EPS = 1e-6f;
constexpr int N_PHASES = 9;
#ifndef MK_N_LAUNCHES
#define MK_N_LAUNCHES 1
#endif
constexpr int N_LAUNCHES = MK_N_LAUNCHES;
constexpr size_t MiB = 1u << 20;
constexpr size_t WS_CTL = 0, CTL_ZERO_BYTES = 1 * MiB;
constexpr size_t WS_W_IN = 2 * MiB, WS_W_CO = 16 * MiB, WS_W_AO = 18 * MiB, WS_W_O = 20 * MiB, WS_W_GU = 22 * MiB, WS_W_D = 33 * MiB;
constexpr size_t WS_KPART = 39 * MiB, WS_LPART = 40 * MiB, WS_SSQ = 43 * MiB, WS_LISTS = 44 * MiB;
constexpr int LIST_PER_BH = 516096;
constexpr size_t WS_A1 = 60 * MiB, WS_A2 = 124 * MiB, WS_A3 = 188 * MiB, WS_A4 = 252 * MiB, WS_A5 = 316 * MiB, WS_A6 = 380 * MiB, WS_A7 = 444 * MiB, WS_END = 508 * MiB;
static_assert(WS_LISTS + (size_t)LIST_PER_BH * 16 * 2 <= WS_A1 && WS_W_D + (size_t)D * DFF * 2 <= WS_KPART && WS_W_GU + (size_t)2 * DFF * D * 2 <= WS_W_D, "ws map");
static_assert((size_t)M * DFF * 2 <= 3 * 64 * MiB, "act fits A3..A5");
constexpr int CW_TMO = 0, CW_CODE = 1, CW_BAR = 4096, CW_GCOUNT = 16384;
constexpr int RING_OFF = 0, RING_BYTES = 131072, EPX_OFF = RING_BYTES, EPX_BYTES = 8192;
constexpr int LDSCTL_OFF = EPX_OFF + EPX_BYTES, MISC_OFF = LDSCTL_OFF + 320;
constexpr int LDS_BYTES = 147456;
static_assert(MISC_OFF + 128 <= LDS_BYTES, "LDS map");
#define GAS __attribute__((address_space(1)))
#define LAS __attribute__((address_space(3)))
typedef unsigned short bf16;
typedef unsigned v4u __attribute__((ext_vector_type(4)));
typedef float f32x4 __attribute__((ext_vector_type(4)));
typedef short bf16x8 __attribute__((ext_vector_type(8)));
typedef GAS unsigned gu32;
typedef GAS unsigned long long gu64;
#define RLX_AGENT __ATOMIC_RELAXED, __HIP_MEMORY_SCOPE_AGENT
#define LDS_WAIT() asm volatile("s_waitcnt lgkmcnt(0)" ::: "memory")
#define VM_WAIT() asm volatile("s_waitcnt vmcnt(0)" ::: "memory")
__device__ __forceinline__ unsigned long long rt() { return __builtin_amdgcn_s_memrealtime(); }
__device__ __forceinline__ unsigned f2bf(float f) { unsigned u = __builtin_bit_cast(unsigned, f); return (u + 0x7fffu + ((u >> 16) & 1u)) >> 16; }
__device__ __forceinline__ unsigned pk2(float lo, float hi) { return f2bf(lo) | (f2bf(hi) << 16); }

#define XB_TMO      128
#define XB_XCNT(j)  (256  + 64 * (j))
#define XB_XSUB(j)  (1280 + 64 * (j))
#define XB_XGEN(j)  (2304 + 64 * (j))
#define XB_TOP      3328
#define XB_TOPGEN   3392
#define XCD_BAR_WORDS 3456
#define XB_SPIN_CAP (1u << 18)

__device__ __forceinline__ unsigned xb_ld(unsigned* p)              { return __hip_atomic_load(p, __ATOMIC_RELAXED, __HIP_MEMORY_SCOPE_AGENT); }
__device__ __forceinline__ unsigned xb_add(unsigned* p, unsigned v) { return __hip_atomic_fetch_add(p, v, __ATOMIC_RELAXED, __HIP_MEMORY_SCOPE_AGENT); }
__device__ __forceinline__ unsigned xb_xcc_id() { return (unsigned)__builtin_amdgcn_s_getreg((3 << 11) | 20) & 0xFu; }
#define XB_SPIN(cond, bar) do { unsigned _sp = 0; while (cond) { __builtin_amdgcn_s_sleep(1); \
    if ((++_sp & 255u) == 0u) { if (xb_ld(&(bar)[XB_TMO])) break; if (_sp > XB_SPIN_CAP) { atomicAdd(&(bar)[XB_TMO], 1u); break; } } } } while (0)

struct XcdBarrier {
    unsigned* bar; unsigned x;
    volatile LAS unsigned* st;
};

__device__ __forceinline__ XcdBarrier xcd_barrier_post(unsigned* bar, volatile LAS unsigned* st) {
    XcdBarrier b; b.bar = bar; b.x = xb_xcc_id(); b.st = st;
    if (threadIdx.x == 0) (void)xb_add(&bar[XB_XCNT(b.x)], 1u);
    return b;
}
__device__ __forceinline__ void xcd_barrier_complete(unsigned* bar, unsigned x, unsigned& nloc, unsigned& nx) {
    const unsigned G = gridDim.x * gridDim.y * gridDim.z;
    unsigned sum, cnt, mine, sp = 0u;
    for (;;) {
        sum = 0u; cnt = 0u; mine = 0u;
#pragma unroll
        for (unsigned j = 0; j < 16; ++j) { const unsigned c = xb_ld(&bar[XB_XCNT(j)]); sum += c; cnt += (c > 0u) ? 1u : 0u; mine = (j == x) ? c : mine; }
        if (sum == G) break;
        __builtin_amdgcn_s_sleep(1);
        if ((++sp & 255u) == 0u) { if (xb_ld(&bar[XB_TMO])) break; if (sp > XB_SPIN_CAP) { atomicAdd(&bar[XB_TMO], 1u); break; } }
    }
    nloc = mine > 0u ? mine : 1u; nx = cnt > 0u ? cnt : 1u;
}

__device__ __forceinline__ void xcd_barrier(const XcdBarrier& b) {
    asm volatile("s_waitcnt vmcnt(0)" ::: "memory");
    __syncthreads();
    if (threadIdx.x == 0) {
        unsigned* bar = b.bar;
        __builtin_amdgcn_s_waitcnt(0);
        unsigned nloc = b.st[0], nx = b.st[1];
        if (nloc == 0u) { xcd_barrier_complete(bar, b.x, nloc, nx); b.st[0] = nloc; b.st[1] = nx; }
        const unsigned old = xb_add(&bar[XB_XSUB(b.x)], 1u);
        const unsigned gen = old / nloc;
        if (old + 1u == (gen + 1u) * nloc) {
            __builtin_amdgcn_fence(__ATOMIC_RELEASE, "agent");
            asm volatile("s_waitcnt vmcnt(0)" ::: "memory");
            const unsigned og = xb_add(&bar[XB_TOP], 1u);
            const unsigned tg = og / nx;
            if (og + 1u == (tg + 1u) * nx) xb_add(&bar[XB_TOPGEN], 1u);
            else XB_SPIN(xb_ld(&bar[XB_TOPGEN]) == tg, bar);
            __builtin_amdgcn_fence(__ATOMIC_ACQUIRE, "agent");
            xb_add(&bar[XB_XGEN(b.x)], 1u);
            asm volatile("s_waitcnt vmcnt(0)" ::: "memory");
        } else {
            XB_SPIN(xb_ld(&bar[XB_XGEN(b.x)]) == gen, bar);
            __builtin_amdgcn_fence(__ATOMIC_ACQUIRE, "agent");
            asm volatile("s_waitcnt vmcnt(0)" ::: "memory");
        }
    }
    __syncthreads();
}
typedef unsigned u32x2 __attribute__((ext_vector_type(2)));
typedef float f32x2v __attribute__((ext_vector_type(2)));
typedef float f32x16 __attribute__((ext_vector_type(16)));
typedef short s16x4 __attribute__((ext_vector_type(4)));
struct Args { const float* in[16]; float* out; unsigned char* ws; int ph_lo, ph_hi, li, pad; };
enum { IN_X = 0, IN_N1G, IN_WIN, IN_DWW, IN_DWB, IN_CLNG, IN_CLNB, IN_WCO, IN_QNG, IN_KNG, IN_WAO, IN_WO, IN_N2G, IN_WFG, IN_WFU, IN_WFD };
struct Frame {
    LAS unsigned char* lds;
    volatile LAS unsigned* MISC;
    gu32* ctl;
    unsigned char* ws; float* out;
    int wave, vcu, G;
};
#define TID_ ((int)threadIdx.x)
#define LANE_ ((int)threadIdx.x & 63)
#define WSB(off) ((bf16*)(F.ws + (off)))
#define WSF(off) ((float*)(F.ws + (off)))
__device__ __forceinline__ float wave_sum(float v) {
#pragma unroll
    for (int o = 1; o < 64; o <<= 1) v += __shfl_xor(v, o);
    return v;
}
__device__ __forceinline__ float wave_max(float v) {
#pragma unroll
    for (int o = 1; o < 64; o <<= 1) v = fmaxf(v, __shfl_xor(v, o));
    return v;
}
__device__ __forceinline__ float bf_lo(unsigned u) { return __uint_as_float(u << 16); }
__device__ __forceinline__ float bf_hi(unsigned u) { return __uint_as_float(u & 0xffff0000u); }
__device__ __forceinline__ void p0_transpose_item(const float* W, int K, int N, bf16* WT, int k0, int n0, int drow0, LAS float* scr, int lane) {
#pragma unroll 8
    for (int i = 0; i < 32; ++i) { const int kk = 2 * i + (lane >> 5); scr[kk * 33 + (lane & 31)] = W[(size_t)(k0 + kk) * N + n0 + (lane & 31)]; }
    LDS_WAIT(); asm volatile("" ::: "memory");
    const int c = lane & 7;
#pragma unroll
    for (int j = 0; j < 4; ++j) { const int n = (lane >> 3) + 8 * j; const LAS float* s = scr + (8 * c) * 33 + n;
        v4u o; o.x = pk2(s[0 * 33], s[1 * 33]); o.y = pk2(s[2 * 33], s[3 * 33]); o.z = pk2(s[4 * 33], s[5 * 33]); o.w = pk2(s[6 * 33], s[7 * 33]);
        *(GAS v4u*)(WT + (size_t)(drow0 + n) * K + k0 + 8 * c) = o; }
    LDS_WAIT(); asm volatile("" ::: "memory");
}
__device__ __forceinline__ void rms_row_to_bf16(Frame& F, const float* xrow, const float* g, bf16* orow) {
    const GAS f32x4* xr = (const GAS f32x4*)xrow + LANE_; const GAS f32x4* gr = (const GAS f32x4*)g + LANE_;
    f32x4 v[4]; float s2 = 0.f;
#pragma unroll
    for (int j = 0; j < 4; ++j) { v[j] = xr[64 * j]; s2 += (v[j].x * v[j].x + v[j].y * v[j].y) + (v[j].z * v[j].z + v[j].w * v[j].w); }
    const float rstd = 1.f / sqrtf(wave_sum(s2) * (1.f / D) + LN_EPS);
    GAS unsigned long long* o8 = (GAS unsigned long long*)orow + LANE_;
#pragma unroll
    for (int j = 0; j < 4; ++j) { const f32x4 gg = gr[64 * j];
        o8[64 * j] = (unsigned long long)pk2(v[j].x * rstd * gg.x, v[j].y * rstd * gg.y) | ((unsigned long long)pk2(v[j].z * rstd * gg.z, v[j].w * rstd * gg.w) << 32); }
}
__device__ __forceinline__ void p0_prologue(Frame& F, const Args& A) {
    LAS float* scr = (LAS float*)(F.lds + RING_OFF + F.wave * 16384);
    const int gw = F.vcu * NWAVES + F.wave, NGW = F.G * NWAVES;
    constexpr int I_IN = (D / 64) * (NIN / 32), I_SQ = (D / 64) * (D / 32), I_GU = (D / 64) * (DFF / 32), I_DN = (DFF / 64) * (D / 32);
    for (int r = gw; r < I_IN; r += NGW) { const int nblk = NIN / 32, kb = r / nblk, n0 = 32 * (r % nblk); int drow;
        if (n0 < 2048) { const int isg = n0 >= 1024, c = n0 - 1024 * isg; drow = 256 * (c >> 7) + 128 * isg + (c & 127); } else drow = n0;
        p0_transpose_item(A.in[IN_WIN], D, NIN, WSB(WS_W_IN), 64 * kb, n0, drow, scr, LANE_); }
    for (int r = gw; r < I_SQ; r += NGW) { const int nblk = D / 32, kb = r / nblk, n0 = 32 * (r % nblk); p0_transpose_item(A.in[IN_WCO], D, D, WSB(WS_W_CO), 64 * kb, n0, n0, scr, LANE_); }
    for (int r = gw; r < I_SQ; r += NGW) { const int nblk = D / 32, kb = r / nblk, n0 = 32 * (r % nblk); p0_transpose_item(A.in[IN_WAO], D, D, WSB(WS_W_AO), 64 * kb, n0, n0, scr, LANE_); }
    for (int r = gw; r < I_SQ; r += NGW) { const int nblk = D / 32, kb = r / nblk, n0 = 32 * (r % nblk); p0_transpose_item(A.in[IN_WO], D, D, WSB(WS_W_O), 64 * kb, n0, n0, scr, LANE_); }
    for (int r = gw; r < I_GU; r += NGW) { const int nblk = DFF / 32, kb = r / nblk, n0 = 32 * (r % nblk); p0_transpose_item(A.in[IN_WFG], D, DFF, WSB(WS_W_GU), 64 * kb, n0, 256 * (n0 >> 7) + (n0 & 127), scr, LANE_); }
    for (int r = gw; r < I_GU; r += NGW) { const int nblk = DFF / 32, kb = r / nblk, n0 = 32 * (r % nblk); p0_transpose_item(A.in[IN_WFU], D, DFF, WSB(WS_W_GU), 64 * kb, n0, 256 * (n0 >> 7) + 128 + (n0 & 127), scr, LANE_); }
    for (int r = gw; r < I_DN; r += NGW) { const int nblk = D / 32, kb = r / nblk, n0 = 32 * (r % nblk); p0_transpose_item(A.in[IN_WFD], DFF, D, WSB(WS_W_D), 64 * kb, n0, n0, scr, LANE_); }
    for (int m = gw; m < M; m += NGW) rms_row_to_bf16(F, A.in[IN_X] + (size_t)m * D, A.in[IN_N1G], WSB(WS_A1) + (size_t)m * D);
}
__device__ __forceinline__ void conv_unit(Frame& F, const Args& A, int unit) {
    const int b = unit >> 9, t0 = (unit & 511) * 32, c0 = 2 * TID_;
    LAS float* ys = (LAS float*)(F.lds + RING_OFF);
    const bf16* ab = WSB(WS_A2) + (size_t)b * SEQ * D + c0;
    unsigned in[62];
#pragma unroll
    for (int i = 0; i < 62; ++i) { const int t = t0 - 30 + i; in[i] = (t >= 0) ? *(const GAS unsigned*)(ab + (size_t)t * D) : 0u; }
    float w0[CKW], w1[CKW];
#pragma unroll
    for (int j = 0; j < CKW; ++j) { const float2 w = *(const float2*)(A.in[IN_DWW] + j * D + c0); w0[j] = w.x; w1[j] = w.y; }
    const float2 bias = *(const float2*)(A.in[IN_DWB] + c0);
#pragma unroll
    for (int tt = 0; tt < 32; ++tt) {
        float y0 = bias.x, y1 = bias.y;
#pragma unroll
        for (int j = 0; j < CKW; ++j) { y0 = fmaf(w0[j], bf_lo(in[tt + j]), y0); y1 = fmaf(w1[j], bf_hi(in[tt + j]), y1); }
        *(LAS f32x2v*)(ys + tt * 1024 + c0) = (f32x2v){y0, y1};
    }
    LDS_WAIT(); __syncthreads();
#pragma unroll 1
    for (int q = 0; q < 4; ++q) {
        const int tt = F.wave * 4 + q; const LAS f32x4* yr = (const LAS f32x4*)(ys + tt * 1024) + LANE_;
        f32x4 v[4]; float s = 0.f;
#pragma unroll
        for (int j = 0; j < 4; ++j) { v[j] = yr[64 * j]; s += (v[j].x + v[j].y) + (v[j].z + v[j].w); }
        const float mean = wave_sum(s) * (1.f / D); float s2 = 0.f;
#pragma unroll
        for (int j = 0; j < 4; ++j) { v[j] = v[j] - mean; s2 += (v[j].x * v[j].x + v[j].y * v[j].y) + (v[j].z * v[j].z + v[j].w * v[j].w); }
        const float rstd = 1.f / sqrtf(wave_sum(s2) * (1.f / D) + LN_EPS);
        GAS unsigned long long* o8 = (GAS unsigned long long*)(WSB(WS_A1) + ((size_t)b * SEQ + t0 + tt) * D) + LANE_;
#pragma unroll
        for (int j = 0; j < 4; ++j) { const f32x4 gg = ((const GAS f32x4*)A.in[IN_CLNG])[64 * j + LANE_], bb = ((const GAS f32x4*)A.in[IN_CLNB])[64 * j + LANE_];
            f32x4 y = v[j] * rstd * gg + bb;
            y.x = y.x * pg8::sigm(y.x); y.y = y.y * pg8::sigm(y.y); y.z = y.z * pg8::sigm(y.z); y.w = y.w * pg8::sigm(y.w);
            o8[64 * j] = (unsigned long long)pk2(y.x, y.y) | ((unsigned long long)pk2(y.z, y.w) << 32); }
    }
    __syncthreads();
}
__device__ __forceinline__ int crow(int r, int hi) { return (r & 3) + 8 * (r >> 2) + 4 * hi; }
__device__ __forceinline__ int list_off(int j) { return 16384 * j - 128 * j * (j + 1); }
#define TOP_INS(val, idx) do { const float v_ = (val); const int i_ = (idx); \
    if (v_ > v1 || (v_ == v1 && i_ < i1)) { v3 = v2; i3 = i2; v2 = v1; i2 = i1; v1 = v_; i1 = i_; } \
    else if (v_ > v2 || (v_ == v2 && i_ < i2)) { v3 = v2; i3 = i2; v2 = v_; i2 = i_; } \
    else if (v_ > v3 || (v_ == v3 && i_ < i3)) { v3 = v_; i3 = i_; } } while (0)
__device__ __forceinline__ void route_unit(Frame& F, int b, int h, int cur) {
    const int lane = LANE_, r32 = lane & 31, hi = lane >> 5, wid = F.wave, bh = b * NH + h;
    LAS unsigned char* kmimg = F.lds + RING_OFF; LAS unsigned* cnt = (LAS unsigned*)(F.lds + RING_OFF + 16384); LAS unsigned* base = cnt + 64;
    if (TID_ < 64) cnt[TID_] = 0u;
    {
        const int row = TID_ >> 3, c2 = (TID_ & 7) * 2; const float* kp = WSF(WS_KPART) + ((size_t)(bh * NB + row) * 2) * DH + c2 * 8;
#pragma unroll
        for (int cc = 0; cc < 2; ++cc) {
            const f32x4 a0 = *(const GAS f32x4*)(kp + 8 * cc), a1 = *(const GAS f32x4*)(kp + 8 * cc + 4), b0 = *(const GAS f32x4*)(kp + DH + 8 * cc), b1 = *(const GAS f32x4*)(kp + DH + 8 * cc + 4);
            const f32x4 m0 = (a0 + b0) * (1.0f / 256.0f), m1 = (a1 + b1) * (1.0f / 256.0f);
            const v4u w = (v4u){pk2(m0.x, m0.y), pk2(m0.z, m0.w), pk2(m1.x, m1.y), pk2(m1.z, m1.w)};
            *(LAS v4u*)(kmimg + 256 * row + 16 * ((c2 + cc) ^ (((row & 3) << 2) | ((row >> 2) & 3)))) = w; }
    }
    const int t = cur * LBLK + wid * 32 + r32;
    const bf16* qp = WSB(WS_A3) + ((size_t)b * SEQ + t) * D + h * DH + hi * 8;
    bf16x8 qf[8];
#pragma unroll
    for (int d0 = 0; d0 < 8; ++d0) qf[d0] = *(const GAS bf16x8*)(qp + 16 * d0);
    float v1 = -INFINITY, v2 = -INFINITY, v3 = -INFINITY; int i1 = 1 << 20, i2 = 1 << 20, i3 = 1 << 20;
    const int ng = (cur + 31) >> 5;
    const int kx = ((r32 & 3) << 2) | ((r32 >> 2) & 3);
    LDS_WAIT(); __syncthreads();
#pragma unroll 1
    for (int g = 0; g < ng; ++g) {
        f32x16 s;
#pragma unroll
        for (int r = 0; r < 16; ++r) s[r] = 0.f;
        const LAS unsigned char* kg = kmimg + 256 * (32 * g + r32);
#pragma unroll
        for (int d0 = 0; d0 < 8; ++d0) { const bf16x8 kf = *(const LAS bf16x8*)(kg + 16 * ((2 * d0 + hi) ^ kx)); s = __builtin_amdgcn_mfma_f32_32x32x16_bf16(kf, qf[d0], s, 0, 0, 0); }
#pragma unroll
        for (int r = 0; r < 16; ++r) { const int jj = 32 * g + crow(r, hi); const float val = (jj < cur) ? s[r] : -INFINITY; TOP_INS(val, jj); }
    }
    {
        const float p1 = __shfl_xor(v1, 32), p2 = __shfl_xor(v2, 32), p3 = __shfl_xor(v3, 32); const int j1 = __shfl_xor(i1, 32), j2 = __shfl_xor(i2, 32), j3 = __shfl_xor(i3, 32);
        TOP_INS(p1, j1); TOP_INS(p2, j2); TOP_INS(p3, j3);
    }
    const int nsel = cur < TOPK ? cur : TOPK;
    unsigned pos0 = 0, pos1 = 0, pos2 = 0;
    if (hi == 0) { pos0 = __hip_atomic_fetch_add(cnt + i1, 1u, __ATOMIC_RELAXED, __HIP_MEMORY_SCOPE_WORKGROUP);
        if (nsel > 1) pos1 = __hip_atomic_fetch_add(cnt + i2, 1u, __ATOMIC_RELAXED, __HIP_MEMORY_SCOPE_WORKGROUP);
        if (nsel > 2) pos2 = __hip_atomic_fetch_add(cnt + i3, 1u, __ATOMIC_RELAXED, __HIP_MEMORY_SCOPE_WORKGROUP); }
    LDS_WAIT(); __syncthreads();
    if (TID_ < 64) { const unsigned c = cnt[TID_]; if (c) base[TID_] = __hip_atomic_fetch_add((unsigned*)(F.ctl + CW_GCOUNT + bh * NB + TID_), c, __ATOMIC_RELAXED, __HIP_MEMORY_SCOPE_AGENT); }
    LDS_WAIT(); __syncthreads();
    if (hi == 0) { unsigned short* L = (unsigned short*)(F.ws + WS_LISTS) + (size_t)bh * LIST_PER_BH;
        L[list_off(i1) + base[i1] + pos0] = (unsigned short)((t << 2) | 0);
        if (nsel > 1) L[list_off(i2) + base[i2] + pos1] = (unsigned short)((t << 2) | 1);
        if (nsel > 2) L[list_off(i3) + base[i3] + pos2] = (unsigned short)((t << 2) | 2); }
    LDS_WAIT(); __syncthreads();
}
__device__ __forceinline__ bf16* opart_ptr(Frame& F, int slot) { return slot == 0 ? WSB(WS_A2) : ((bf16*)F.out + (size_t)(slot - 1) * M * D); }
template <bool OWN>
__device__ __forceinline__ void attn_unit(Frame& F, int b, int h, int j, int nrows, const unsigned short* list, int nsel, float M2) {
    const int lane = LANE_, r32 = lane & 31, hi = lane >> 5, wid = F.wave;
    LAS unsigned char* Kimg = F.lds + RING_OFF; LAS unsigned char* Vimg = F.lds + RING_OFF + 65536;
    {
        const bf16* Kg = WSB(WS_A4) + ((size_t)b * SEQ + (size_t)j * LBLK) * D + h * DH; const bf16* Vg = WSB(WS_A5) + ((size_t)b * SEQ + (size_t)j * LBLK) * D + h * DH;
#pragma unroll
        for (int i = 0; i < 8; ++i) {
            const int piece = wid * 8 + i, row = piece * 4 + (lane >> 4), ch = (lane & 15) ^ (((row & 3) << 2) | ((row >> 2) & 3));
            __builtin_amdgcn_global_load_lds((const unsigned*)(Kg + (size_t)row * D + ch * 8), (LAS unsigned*)(Kimg + piece * 1024), 16, 0, 0);
            __builtin_amdgcn_global_load_lds((const unsigned*)(Vg + (size_t)row * D + ch * 8), (LAS unsigned*)(Vimg + piece * 1024), 16, 0, 0);
        }
    }
    const int li = wid * 32 + r32; const bool valid = li < nrows; const bool wave_on = wid * 32 < nrows;
    int tq, slot = 0;
    if (OWN) tq = j * LBLK + li; else { const unsigned e = list[valid ? li : 0]; tq = (int)(e >> 2); slot = (int)(e & 3u); }
    const size_t qrow = (size_t)b * SEQ + tq;
    bf16x8 qf[8];
    { const bf16* qp = WSB(WS_A3) + qrow * D + h * DH + hi * 8;
#pragma unroll
      for (int d0 = 0; d0 < 8; ++d0) qf[d0] = *(const GAS bf16x8*)(qp + 16 * d0); }
    const float slope2 = __builtin_amdgcn_exp2f(-(float)(h + 1)) * 1.4426950408889634f;
    f32x16 o[4];
#pragma unroll
    for (int c = 0; c < 4; ++c)
#pragma unroll
        for (int r = 0; r < 16; ++r) o[c][r] = 0.f;
    float lsum = 0.f;
    VM_WAIT(); __syncthreads();
    if (wave_on) {
        const int kx = ((r32 & 3) << 2) | ((r32 >> 2) & 3);
        const LAS unsigned char* kbase = Kimg + 256 * r32;
        const int qq = (lane & 15) >> 2, pp = lane & 3, blk = (lane >> 4) & 1;
        const LAS unsigned char* vbase = Vimg + 256 * (4 * hi + qq) + 8 * (pp & 1);
        int voff[4][2];
#pragma unroll
        for (int c = 0; c < 4; ++c)
#pragma unroll
            for (int t = 0; t < 2; ++t) voff[c][t] = 16 * (4 * (c ^ qq) + ((2 * blk + (pp >> 1)) ^ (2 * t + hi))) + 2048 * t;
        const int ng = OWN ? (wid + 1) : 8;
#pragma unroll 1
        for (int g = 0; g < ng; ++g) {
            f32x16 s;
#pragma unroll
            for (int r = 0; r < 16; ++r) s[r] = 0.f;
            const LAS unsigned char* kg = kbase + 8192 * g;
#pragma unroll
            for (int d0 = 0; d0 < 8; ++d0) { const bf16x8 kf = *(const LAS bf16x8*)(kg + 16 * ((2 * d0 + hi) ^ kx)); s = __builtin_amdgcn_mfma_f32_32x32x16_bf16(kf, qf[d0], s, 0, 0, 0); }
            const int kpos0 = j * LBLK + 32 * g + 4 * hi;
            const float base = slope2 * (float)(kpos0 - tq) - M2;
            float p[16];
#pragma unroll
            for (int r = 0; r < 16; ++r) { const int off = (r & 3) + 8 * (r >> 2); float a = s[r] + (base + slope2 * (float)off);
                if (OWN) a = (kpos0 + off > tq) ? -INFINITY : a;
                p[r] = __builtin_amdgcn_exp2f(a); lsum += p[r]; }
            v4u pk0, pk1;
            pk0.x = pg8::cvt_pk_bf16(p[0], p[1]); pk0.y = pg8::cvt_pk_bf16(p[2], p[3]); pk0.z = pg8::cvt_pk_bf16(p[4], p[5]); pk0.w = pg8::cvt_pk_bf16(p[6], p[7]);
            pk1.x = pg8::cvt_pk_bf16(p[8], p[9]); pk1.y = pg8::cvt_pk_bf16(p[10], p[11]); pk1.z = pg8::cvt_pk_bf16(p[12], p[13]); pk1.w = pg8::cvt_pk_bf16(p[14], p[15]);
            const bf16x8 pb0 = __builtin_bit_cast(bf16x8, pk0), pb1 = __builtin_bit_cast(bf16x8, pk1);
            const LAS unsigned char* vg = vbase + 8192 * g;
#pragma unroll
            for (int c = 0; c < 4; ++c) {
#pragma unroll
                for (int s2 = 0; s2 < 2; ++s2) {
                    const s16x4 lo = __builtin_bit_cast(s16x4, __builtin_amdgcn_ds_read_tr16_b64_v4i16((LAS s16x4*)(vg + 4096 * s2 + voff[c][0])));
                    const s16x4 hh = __builtin_bit_cast(s16x4, __builtin_amdgcn_ds_read_tr16_b64_v4i16((LAS s16x4*)(vg + 4096 * s2 + voff[c][1])));
                    const bf16x8 vf = (bf16x8){lo[0], lo[1], lo[2], lo[3], hh[0], hh[1], hh[2], hh[3]};
                    o[c] = __builtin_amdgcn_mfma_f32_32x32x16_bf16(vf, s2 == 0 ? pb0 : pb1, o[c], 0, 0, 0);
                }
            }
        }
        lsum += __shfl_xor(lsum, 32);
        if (OWN) {
            float l = lsum;
            for (int sl = 0; sl < nsel; ++sl) {
                l += WSF(WS_LPART)[((size_t)sl * M + qrow) * NH + h];
                const bf16* op = opart_ptr(F, sl) + qrow * D + h * DH + 4 * hi;
#pragma unroll
                for (int c = 0; c < 4; ++c)
#pragma unroll
                    for (int gq = 0; gq < 4; ++gq) { const u32x2 w = *(const GAS u32x2*)(op + 32 * c + 8 * gq);
                        o[c][4 * gq + 0] += bf_lo(w.x); o[c][4 * gq + 1] += bf_hi(w.x); o[c][4 * gq + 2] += bf_lo(w.y); o[c][4 * gq + 3] += bf_hi(w.y); }
            }
            const float rl = 1.0f / l;
            bf16* ap = WSB(WS_A3) + qrow * D + h * DH + 4 * hi;
#pragma unroll
            for (int c = 0; c < 4; ++c)
#pragma unroll
                for (int gq = 0; gq < 4; ++gq) { u32x2 w; w.x = pg8::cvt_pk_bf16(o[c][4 * gq] * rl, o[c][4 * gq + 1] * rl); w.y = pg8::cvt_pk_bf16(o[c][4 * gq + 2] * rl, o[c][4 * gq + 3] * rl);
                    *(GAS u32x2*)(ap + 32 * c + 8 * gq) = w; }
        } else if (valid) {
            if (hi == 0) WSF(WS_LPART)[((size_t)slot * M + qrow) * NH + h] = lsum;
            bf16* op = opart_ptr(F, slot) + qrow * D + h * DH + 4 * hi;
#pragma unroll
            for (int c = 0; c < 4; ++c)
#pragma unroll
                for (int gq = 0; gq < 4; ++gq) { u32x2 w; w.x = pg8::cvt_pk_bf16(o[c][4 * gq], o[c][4 * gq + 1]); w.y = pg8::cvt_pk_bf16(o[c][4 * gq + 2], o[c][4 * gq + 3]);
                    *(GAS u32x2*)(op + 32 * c + 8 * gq) = w; }
        }
    }
    LDS_WAIT(); __syncthreads();
}
__global__ void __launch_bounds__(NWAVES * 64, 2) mk_fwd(Args args) {
    extern __shared__ __attribute__((aligned(16))) unsigned char lds[];
    Frame F;
    F.lds = (LAS unsigned char*)lds;
    F.MISC = (volatile LAS unsigned*)(F.lds + MISC_OFF);
    F.wave = __builtin_amdgcn_readfirstlane(TID_ >> 6);
    F.G = gridDim.x; { const int bx = blockIdx.x; F.vcu = (F.G % 8 == 0) ? (bx % 8) * (F.G / 8) + bx / 8 : bx; }
    F.ws = args.ws; F.out = args.out;
    F.ctl = (gu32*)(F.ws + WS_CTL);
    const Args& A = args;
    for (int u = TID_; u < (LDS_BYTES - LDSCTL_OFF) / 4; u += NWAVES * 64) ((LAS unsigned*)(F.lds + LDSCTL_OFF))[u] = 0u;
    __syncthreads();
    XcdBarrier bar; bar.bar = (unsigned*)(F.ctl + CW_BAR); bar.x = 0; bar.st = nullptr;
    if (N_LAUNCHES == 1) bar = xcd_barrier_post((unsigned*)(F.ctl + CW_BAR), F.MISC + 8);
#define GRID_BAR() do { if (N_LAUNCHES == 1) xcd_barrier(bar); } while (0)
    const int lo = args.ph_lo, hi_ph = args.ph_hi;
#ifdef MK_PH
#define IN(k) ((k) == MK_PH)
#else
#define IN(k) (lo <= (k) && (k) < hi_ph)
#endif
#define BOTH(k) (IN(k) && IN((k) + 1))
    LAS float* epx = (LAS float*)(F.lds + EPX_OFF);

    if (IN(0)) { p0_prologue(F, A); if (BOTH(0)) GRID_BAR(); }

    if (IN(1)) {
        pg8::Gemm g{WSB(WS_A1), WSB(WS_W_IN), M, NIN, D}; pg8::StaticOrder S; S.init(M, NIN, F.G, (int)blockIdx.x);
        pg8::EpiInProj E{WSB(WS_A2), WSB(WS_A3), WSB(WS_A5), WSF(WS_KPART), A.in[IN_QNG], A.in[IN_KNG]};
        pg8::gemm_phase<pg8::EpiInProj, pg8::StaticOrder, true, true>(F.lds + RING_OFF, epx, g, S, E);
        if (BOTH(1)) GRID_BAR();
    }
    if (IN(2)) {
        for (int u = F.vcu; u < BATCH * NH * (NB - 1); u += F.G) { const int bh = u / (NB - 1), cur = 1 + u % (NB - 1); route_unit(F, bh >> 3, bh & 7, cur); }
        for (int u = F.vcu; u < M / 32; u += F.G) conv_unit(F, A, u);
        if (BOTH(2)) GRID_BAR();
    }
    float M2;
    { const float a = fmaxf(fabsf(A.in[IN_QNG][LANE_]), fabsf(A.in[IN_QNG][64 + LANE_])), c = fmaxf(fabsf(A.in[IN_KNG][LANE_]), fabsf(A.in[IN_KNG][64 + LANE_]));
      M2 = wave_max(a) * wave_max(c) * (11.313708498984761f * 1.4426950408889634f * 1.01f); }
    if (IN(3)) {
        {
            pg8::Gemm g{WSB(WS_A1), WSB(WS_W_CO), M, D, D}; pg8::StaticOrder S; S.init(M, D, F.G, (int)blockIdx.x);
            pg8::EpiGateMul E{WSB(WS_A6)};
            pg8::gemm_phase<pg8::EpiGateMul, pg8::StaticOrder, true, true>(F.lds + RING_OFF, epx, g, S, E);
        }
        LAS unsigned* pre = (LAS unsigned*)epx;
        {
            const unsigned n0 = __hip_atomic_load(F.ctl + CW_GCOUNT + 2 * TID_, RLX_AGENT), n1 = __hip_atomic_load(F.ctl + CW_GCOUNT + 2 * TID_ + 1, RLX_AGENT);
            const unsigned u0 = (n0 + 255u) >> 8, u1 = (n1 + 255u) >> 8; unsigned s = u0 + u1;
#pragma unroll
            for (int o = 1; o < 64; o <<= 1) { const unsigned t = __shfl_up(s, o); if (LANE_ >= o) s += t; }
            LAS unsigned* wt = pre + 1032;
            if (LANE_ == 63) wt[F.wave] = s;
            LDS_WAIT(); __syncthreads();
            unsigned wb = 0; for (int w = 0; w < F.wave; ++w) wb += wt[w];
            const unsigned excl = wb + s - (u0 + u1);
            pre[2 * TID_] = excl; pre[2 * TID_ + 1] = excl + u0;
            if (TID_ == NWAVES * 64 - 1) pre[1024] = excl + u0 + u1;
            LDS_WAIT(); __syncthreads();
        }
        const int total = (int)pre[1024];
        for (int u = F.vcu; u < total; u += F.G) {
            int lo_ = 0, hi_ = 1023;
            while (lo_ < hi_) { const int mid = (lo_ + hi_ + 1) >> 1; if ((int)pre[mid] <= u) lo_ = mid; else hi_ = mid - 1; }
            const int L = lo_, ui = u - (int)pre[L], bh = L >> 6, j = L & 63;
            const int n = (int)__hip_atomic_load(F.ctl + CW_GCOUNT + L, RLX_AGENT); const int nrows = (n - ui * 256) < 256 ? (n - ui * 256) : 256;
            attn_unit<false>(F, bh >> 3, bh & 7, j, nrows, (const unsigned short*)(F.ws + WS_LISTS) + (size_t)bh * LIST_PER_BH + list_off(j) + ui * 256, 0, M2);
        }
        __syncthreads();
        if (BOTH(3)) GRID_BAR();
    }
    if (IN(4)) {
        for (int u = F.vcu; u < BATCH * NH * NB; u += F.G) { const int bh = u >> 6, j = u & 63; attn_unit<true>(F, bh >> 3, bh & 7, j, 256, nullptr, j < TOPK ? j : TOPK, M2); }
        if (BOTH(4)) GRID_BAR();
    }
    if (IN(5)) {
        pg8::Gemm g{WSB(WS_A3), WSB(WS_W_AO), M, D, D}; pg8::StaticOrder S; S.init(M, D, F.G, (int)blockIdx.x);
        pg8::EpiMerge E{WSB(WS_A6), WSB(WS_A7), WSB(WS_A1)};
        pg8::gemm_phase<pg8::EpiMerge, pg8::StaticOrder, true, true>(F.lds + RING_OFF, epx, g, S, E);
        if (BOTH(5)) GRID_BAR();
    }
    if (IN(6)) {
        pg8::Gemm g{WSB(WS_A1), WSB(WS_W_O), M, D, D}; pg8::StaticOrder S; S.init(M, D, F.G, (int)blockIdx.x);
        pg8::EpiResNorm E{A.in[IN_X], F.out, WSB(WS_A2), A.in[IN_N2G], WSF(WS_SSQ)};
        pg8::gemm_phase<pg8::EpiResNorm, pg8::StaticOrder, true, true>(F.lds + RING_OFF, epx, g, S, E);
        if (BOTH(6)) GRID_BAR();
    }
    if (IN(7)) {
        pg8::Gemm g{WSB(WS_A2), WSB(WS_W_GU), M, 2 * DFF, D}; pg8::StaticOrder S; S.init(M, 2 * DFF, F.G, (int)blockIdx.x);
        pg8::EpiSwiGLU E{WSF(WS_SSQ), WSB(WS_A3), DFF};
        pg8::gemm_phase<pg8::EpiSwiGLU, pg8::StaticOrder, true, true>(F.lds + RING_OFF, epx, g, S, E);
        if (BOTH(7)) GRID_BAR();
    }
    if (IN(8)) {
        pg8::Gemm g{WSB(WS_A3), WSB(WS_W_D), M, D, DFF}; pg8::StaticOrder S; S.init(M, D, F.G, (int)blockIdx.x);
        pg8::EpiResOut E{F.out};
        pg8::gemm_phase<pg8::EpiResOut, pg8::StaticOrder, true, true>(F.lds + RING_OFF, epx, g, S, E);
    }
#undef IN
#undef BOTH
}

extern "C" void kernel_launch(void* const* d_in, const int* in_sizes, int n_in, void* d_out, int out_size, void* d_ws, size_t ws_size, hipStream_t stream) {
    static int grid = 0;
    if (grid == 0) {
        if (n_in != 16 || in_sizes[0] != M * D || out_size != M * D || ws_size < WS_END) { fprintf(stderr, "kernel_launch: unexpected shapes / workspace (n_in %d, in0 %d, out %d, ws %zu); nothing launched\n", n_in, n_in > 0 ? in_sizes[0] : -1, out_size, ws_size); grid = -1; return; }
        int dev = 0, cus = 0;
        if (hipGetDevice(&dev) != hipSuccess || hipDeviceGetAttribute(&cus, hipDeviceAttributeMultiprocessorCount, dev) != hipSuccess) { grid = -1; return; }
        if (hipFuncSetAttribute((const void*)mk_fwd, hipFuncAttributeMaxDynamicSharedMemorySize, LDS_BYTES) != hipSuccess) { fprintf(stderr, "kernel_launch: hipFuncSetAttribute failed\n"); grid = -1; return; }
        int per_cu = 0;
        if (hipOccupancyMaxActiveBlocksPerMultiprocessor(&per_cu, (const void*)mk_fwd, NWAVES * 64, LDS_BYTES) != hipSuccess || per_cu < 1) fprintf(stderr, "kernel_launch: occupancy query reports %d\n", per_cu);
        (void)hipGetLastError();
        grid = cus;
    }
    if (grid < 0) return;
    if (hipMemsetAsync((char*)d_ws + WS_CTL, 0, CTL_ZERO_BYTES, stream) != hipSuccess) return;
    Args a{};
    for (int i = 0; i < 16; ++i) a.in[i] = (const float*)d_in[i];
    a.out = (float*)d_out; a.ws = (unsigned char*)d_ws;
    for (int li = 0; li < N_LAUNCHES; ++li) {
        a.ph_lo = (N_LAUNCHES == 1) ? 0 : li; a.ph_hi = (N_LAUNCHES == 1) ? N_PHASES : li + 1; a.li = li;
        hipLaunchKernelGGL(mk_fwd, dim3(grid), dim3(NWAVES * 64), LDS_BYTES, stream, a);
    }
}
```

```cpp
#include <hip/hip_runtime.h>
#include <cstdio>
#include <cstdint>
namespace pg8 {
#define PG8_LAS __attribute__((address_space(3)))
typedef unsigned short bf16_t;
typedef short bf16x8 __attribute__((ext_vector_type(8)));
typedef float f32x4 __attribute__((ext_vector_type(4)));
typedef unsigned u32x4 __attribute__((ext_vector_type(4)));
constexpr int BM = 256, BK = 64, HALF = 128, HTB = HALF * BK * 2  , STAGE_BYTES = 8 * HTB, NXCD = 8, WGM = 8;

__host__ __device__ __forceinline__ int lds_byte(int r, int c) { const int st = (r >> 4) * 2 + (c >> 5), rr = r & 15, cc = c & 31, ob = rr * 64 + cc * 2; return st * 1024 + (ob ^ (((ob >> 9) & 1) << 5)); }
__host__ __device__ __forceinline__ void stage_rc(int b, int& R, int& C) { const int st = b / 1024, sb = b % 1024, swz = sb ^ (((sb >> 9) & 1) << 5); R = (st >> 1) * 16 + swz / 64; C = (st & 1) * 32 + (swz % 64) / 2; }
__host__ __device__ __forceinline__ int perm32(int rho) { const int n = rho >> 4, i = rho & 15; return 8 * (i >> 2) + 4 * n + (i & 3); }

struct Unit { int pm, pn; };
struct Gemm { const bf16_t* A; const bf16_t* Bt; int M, N, K; };

struct StaticOrder {
    int nM, nN, nwg, G, c;
    __host__ __device__ void init(int M, int N, int G_, int c_) { nM = M / BM; nN = N / BM; nwg = nM * nN; G = G_; c = c_; }
    __host__ __device__ bool next(int i, Unit& u) const {
        const long L = (long)i * G + c; if (L >= nwg) return false;
        int wgid = (int)L; { const int q = nwg / NXCD, r = nwg % NXCD, xcd = wgid % NXCD, off = wgid / NXCD; wgid = (xcd < r ? xcd * (q + 1) : r * (q + 1) + (xcd - r) * q) + off; }
        const int nig = WGM * nN, gid = wgid / nig, fm = gid * WGM, gsz = (nM - fm) < WGM ? (nM - fm) : WGM;
        u.pm = fm + ((wgid % nig) % gsz); u.pn = (wgid % nig) / gsz; return true;
    }
    __device__ __forceinline__ void a_ready(const Unit&) const {}
    __device__ __forceinline__ void done(const Unit&) const {}
};

__device__ __forceinline__ unsigned cvt_pk_bf16(float lo, float hi) { unsigned r; asm volatile("v_cvt_pk_bf16_f32 %0, %1, %2" : "=v"(r) : "v"(lo), "v"(hi)); return r; }
__device__ __forceinline__ u32x4 pack8(const f32x4 a, const f32x4 b) { u32x4 w; w.x = cvt_pk_bf16(a[0], a[1]); w.y = cvt_pk_bf16(a[2], a[3]); w.z = cvt_pk_bf16(b[0], b[1]); w.w = cvt_pk_bf16(b[2], b[3]); return w; }
__device__ __forceinline__ void unpack8(const u32x4 w, f32x4& a, f32x4& b) {
    a[0] = __uint_as_float(w.x << 16); a[1] = __uint_as_float(w.x & 0xffff0000u); a[2] = __uint_as_float(w.y << 16); a[3] = __uint_as_float(w.y & 0xffff0000u);
    b[0] = __uint_as_float(w.z << 16); b[1] = __uint_as_float(w.z & 0xffff0000u); b[2] = __uint_as_float(w.w << 16); b[3] = __uint_as_float(w.w & 0xffff0000u); }
__device__ __forceinline__ float sigm(float x) { return __builtin_amdgcn_rcpf(1.f + __builtin_amdgcn_exp2f(-1.4426950408889634f * x)); }
__device__ __forceinline__ f32x4 sigm4(const f32x4 x) { f32x4 r; r[0] = sigm(x[0]); r[1] = sigm(x[1]); r[2] = sigm(x[2]); r[3] = sigm(x[3]); return r; }
__device__ __forceinline__ float dot4(const f32x4 a) { return (a[0] * a[0] + a[1] * a[1]) + (a[2] * a[2] + a[3] * a[3]); }
#define PG8_EPI_BAR() do { asm volatile("s_waitcnt lgkmcnt(0)" ::: "memory"); __builtin_amdgcn_s_barrier(); asm volatile("" ::: "memory"); } while (0)

constexpr float QSCALE = 0.08838834764831845f * 1.4426950408889634f;
constexpr float NORM_EPS = 1e-6f;

struct EpiInProj {
    static constexpr bool PERM = true, AFTER_DRAIN = false;
    bf16_t *a, *q, *v; float* kpart; const float *gq, *gk;
    __device__ __forceinline__ void operator()(const f32x4 (&acc)[2][2][4][2], const Unit& u, int wr, int wc, int fr, int fq, PG8_LAS float* X, int wid, int lane) const {
        asm volatile("" : "+v"(fr), "+v"(fq));
        const int pn = u.pn, row0 = u.pm * BM + wr * 64 + fr, cw = wc * 32 + 8 * fq;
        if (pn < 8) {
#pragma unroll
            for (int ai = 0; ai < 2; ++ai)
#pragma unroll
                for (int m = 0; m < 4; ++m) {
                    const f32x4 o0 = acc[ai][0][m][0] * sigm4(acc[ai][1][m][0]), o1 = acc[ai][0][m][1] * sigm4(acc[ai][1][m][1]);
                    *(u32x4*)(a + (size_t)(row0 + ai * HALF + m * 16) * 1024 + pn * 128 + cw) = pack8(o0, o1); asm volatile("" ::: "memory"); }
        } else if (pn < 16) {
            const bool isk = pn >= 12; const int hd0 = ((pn - 8) & 3) * 2;
            const float* gv = isk ? gk : gq; bf16_t* dst = q + (isk ? ((size_t)32 << 20) : (size_t)0);
            f32x4 g0 = *(const f32x4*)(gv + cw), g1 = *(const f32x4*)(gv + cw + 4);
            if (!isk) { g0 = g0 * QSCALE; g1 = g1 * QSCALE; }
            PG8_LAS float* P = X + wr * 1024;
#pragma unroll
            for (int ai = 0; ai < 2; ++ai)
#pragma unroll
                for (int m = 0; m < 4; ++m)
#pragma unroll
                    for (int bj = 0; bj < 2; ++bj) { float s = dot4(acc[ai][bj][m][0]) + dot4(acc[ai][bj][m][1]); s += __shfl_xor(s, 16); s += __shfl_xor(s, 32);
                        if (fq == 0) P[((ai * 64 + m * 16 + fr) * 2 + bj) * 4 + wc] = s; }
            PG8_EPI_BAR();
#pragma unroll
            for (int bj = 0; bj < 2; ++bj) {
                f32x4 c0 = (f32x4){0.f, 0.f, 0.f, 0.f}, c1 = (f32x4){0.f, 0.f, 0.f, 0.f};
#pragma unroll
                for (int ai = 0; ai < 2; ++ai)
#pragma unroll
                    for (int m = 0; m < 4; ++m) { const f32x4 p = *(const PG8_LAS f32x4*)(P + ((ai * 64 + m * 16 + fr) * 2 + bj) * 4);
                        const float r = __builtin_amdgcn_rsqf(((p[0] + p[1]) + (p[2] + p[3])) * (1.0f / 128.0f) + NORM_EPS);
                        const f32x4 y0 = acc[ai][bj][m][0] * r, y1 = acc[ai][bj][m][1] * r;
                        c0 += y0; c1 += y1;
                        *(u32x4*)(dst + (size_t)(row0 + ai * HALF + m * 16) * 1024 + (hd0 + bj) * 128 + cw) = pack8(y0 * g0, y1 * g1); asm volatile("" ::: "memory"); }
                if (isk) {
                    c0 = c0 * g0; c1 = c1 * g1;
#pragma unroll
                    for (int e = 0; e < 4; ++e) { float s = c0[e]; s += __shfl_xor(s, 1); s += __shfl_xor(s, 2); s += __shfl_xor(s, 4); s += __shfl_xor(s, 8); c0[e] = s;
                        float t = c1[e]; t += __shfl_xor(t, 1); t += __shfl_xor(t, 2); t += __shfl_xor(t, 4); t += __shfl_xor(t, 8); c1[e] = t; }
                    if (fr == 0) { const int b = u.pm >> 6, blk = u.pm & 63; float* kp = kpart + ((size_t)(((b * 8 + hd0 + bj) * 64 + blk) * 2 + wr)) * 128 + cw;
                        *(f32x4*)kp = c0; *(f32x4*)(kp + 4) = c1; }
                }
            }
        } else {
            const int t = (pn - 16) >> 2, cb = ((pn - 16) & 3) * 256;
            bf16_t* dst = v + (size_t)t * ((size_t)32 << 20);
#pragma unroll
            for (int ai = 0; ai < 2; ++ai)
#pragma unroll
                for (int m = 0; m < 4; ++m)
#pragma unroll
                    for (int bj = 0; bj < 2; ++bj) { f32x4 x0 = acc[ai][bj][m][0], x1 = acc[ai][bj][m][1];
                        if (t) { x0 = sigm4(x0); x1 = sigm4(x1); }
                        *(u32x4*)(dst + (size_t)(row0 + ai * HALF + m * 16) * 1024 + cb + bj * HALF + cw) = pack8(x0, x1); asm volatile("" ::: "memory"); }
        }
    }
};
struct EpiGateMul {
    static constexpr bool PERM = true, AFTER_DRAIN = false;
    bf16_t* T;
    __device__ __forceinline__ void operator()(const f32x4 (&acc)[2][2][4][2], const Unit& u, int wr, int wc, int fr, int fq, PG8_LAS float*, int, int) const {
        asm volatile("" : "+v"(fr), "+v"(fq));
        const int row0 = u.pm * BM + wr * 64 + fr, col0 = u.pn * BM + wc * 32 + 8 * fq;
#pragma unroll
        for (int ai = 0; ai < 2; ++ai)
#pragma unroll
            for (int m = 0; m < 4; ++m)
#pragma unroll
                for (int bj = 0; bj < 2; ++bj) { bf16_t* p = T + (size_t)(row0 + ai * HALF + m * 16) * 1024 + col0 + bj * HALF;
                    f32x4 s0, s1; unpack8(*(const u32x4*)p, s0, s1);
                    *(u32x4*)p = pack8(s0 * acc[ai][bj][m][0], s1 * acc[ai][bj][m][1]); asm volatile("" ::: "memory"); }
    }
};
struct EpiMerge {
    static constexpr bool PERM = true, AFTER_DRAIN = false;
    const bf16_t *T1, *SG; bf16_t* O;
    __device__ __forceinline__ void operator()(const f32x4 (&acc)[2][2][4][2], const Unit& u, int wr, int wc, int fr, int fq, PG8_LAS float*, int, int) const {
        asm volatile("" : "+v"(fr), "+v"(fq));
        const int row0 = u.pm * BM + wr * 64 + fr, col0 = u.pn * BM + wc * 32 + 8 * fq;
#pragma unroll
        for (int ai = 0; ai < 2; ++ai)
#pragma unroll
            for (int m = 0; m < 4; ++m)
#pragma unroll
                for (int bj = 0; bj < 2; ++bj) { const size_t off = (size_t)(row0 + ai * HALF + m * 16) * 1024 + col0 + bj * HALF;
                    f32x4 t0, t1, s0, s1; unpack8(*(const u32x4*)(T1 + off), t0, t1); unpack8(*(const u32x4*)(SG + off), s0, s1);
                    *(u32x4*)(O + off) = pack8(t0 + s0 * acc[ai][bj][m][0], t1 + s1 * acc[ai][bj][m][1]); asm volatile("" ::: "memory"); }
    }
};
struct EpiResNorm {
    static constexpr bool PERM = true, AFTER_DRAIN = false;
    const float* x; float* out; bf16_t* hg; const float* g2; float* ssq4;
    __device__ __forceinline__ void operator()(const f32x4 (&acc)[2][2][4][2], const Unit& u, int wr, int wc, int fr, int fq, PG8_LAS float* X, int wid, int lane) const {
        asm volatile("" : "+v"(fr), "+v"(fq));
        const int row0 = u.pm * BM + wr * 64 + fr, col0 = u.pn * BM + wc * 32 + 8 * fq;
        PG8_LAS float* P = X + wr * 1024;
        f32x4 gg[2][2];
#pragma unroll
        for (int bj = 0; bj < 2; ++bj) { gg[bj][0] = *(const f32x4*)(g2 + col0 + bj * HALF); gg[bj][1] = *(const f32x4*)(g2 + col0 + bj * HALF + 4); }
#pragma unroll
        for (int ai = 0; ai < 2; ++ai)
#pragma unroll
            for (int m = 0; m < 4; ++m) { float s = 0.f;
#pragma unroll
                for (int bj = 0; bj < 2; ++bj) { const size_t off = (size_t)(row0 + ai * HALF + m * 16) * 1024 + col0 + bj * HALF;
                    const f32x4 h0 = *(const f32x4*)(x + off) + acc[ai][bj][m][0], h1 = *(const f32x4*)(x + off + 4) + acc[ai][bj][m][1];
                    *(f32x4*)(out + off) = h0; *(f32x4*)(out + off + 4) = h1; s += dot4(h0) + dot4(h1);
                    *(u32x4*)(hg + off) = pack8(h0 * gg[bj][0], h1 * gg[bj][1]); asm volatile("" ::: "memory"); }
                s += __shfl_xor(s, 16); s += __shfl_xor(s, 32);
                if (fq == 0) P[(ai * 64 + m * 16 + fr) * 4 + wc] = s; }
        PG8_EPI_BAR();
        if (wc == 0) {
#pragma unroll
            for (int i = 0; i < 2; ++i) { const int rr = lane + 64 * i; const f32x4 p = *(const PG8_LAS f32x4*)(P + rr * 4);
                const int ai = rr >> 6, rem = rr & 63;
                ssq4[(size_t)(u.pm * BM + ai * HALF + wr * 64 + rem) * 4 + u.pn] = (p[0] + p[1]) + (p[2] + p[3]); }
        }
    }
};
struct EpiSwiGLU {
    static constexpr bool PERM = true, AFTER_DRAIN = false;
    const float* ssq4; bf16_t* act; int ldc;
    __device__ __forceinline__ void operator()(const f32x4 (&acc)[2][2][4][2], const Unit& u, int wr, int wc, int fr, int fq, PG8_LAS float*, int, int) const {
        asm volatile("" : "+v"(fr), "+v"(fq));
        const int row0 = u.pm * BM + wr * 64 + fr, col0 = u.pn * HALF + wc * 32 + 8 * fq;
#pragma unroll
        for (int ai = 0; ai < 2; ++ai)
#pragma unroll
            for (int m = 0; m < 4; ++m) { const int row = row0 + ai * HALF + m * 16; const f32x4 p = *(const f32x4*)(ssq4 + (size_t)row * 4);
                const float r = __builtin_amdgcn_rsqf(((p[0] + p[1]) + (p[2] + p[3])) * (1.0f / 1024.0f) + NORM_EPS);
                const f32x4 g0 = acc[ai][0][m][0] * r, g1 = acc[ai][0][m][1] * r, u0 = acc[ai][1][m][0] * r, u1 = acc[ai][1][m][1] * r;
                *(u32x4*)(act + (size_t)row * ldc + col0) = pack8(g0 * sigm4(g0) * u0, g1 * sigm4(g1) * u1); asm volatile("" ::: "memory"); }
    }
};
struct EpiResOut {
    static constexpr bool PERM = true, AFTER_DRAIN = false;
    float* out;
    __device__ __forceinline__ void operator()(const f32x4 (&acc)[2][2][4][2], const Unit& u, int wr, int wc, int fr, int fq, PG8_LAS float*, int, int) const {
        asm volatile("" : "+v"(fr), "+v"(fq));
        const int row0 = u.pm * BM + wr * 64 + fr, col0 = u.pn * BM + wc * 32 + 8 * fq;
#pragma unroll
        for (int ai = 0; ai < 2; ++ai)
#pragma unroll
            for (int m = 0; m < 4; ++m)
#pragma unroll
                for (int bj = 0; bj < 2; ++bj) { float* p = out + (size_t)(row0 + ai * HALF + m * 16) * 1024 + col0 + bj * HALF;
                    const f32x4 h0 = *(const f32x4*)p + acc[ai][bj][m][0], h1 = *(const f32x4*)(p + 4) + acc[ai][bj][m][1];
                    *(f32x4*)p = h0; *(f32x4*)(p + 4) = h1; asm volatile("" ::: "memory"); }
    }
};
template <class Epi, class Sched, bool ALIGN_EPI = false, bool SP2 = false>
__device__ __forceinline__ void gemm_phase(PG8_LAS unsigned char* lds, PG8_LAS float* epx, const Gemm g, const Sched& S, const Epi& E) {
    const int tid = threadIdx.x, wid = __builtin_amdgcn_readfirstlane(tid >> 6), lane = tid & 63, wr = wid >> 2, wc = wid & 3, fr = lane & 15, fq = lane >> 4;
    const int K = g.K, nt = K / BK;
    unsigned voffA[2], voffB[2];
#pragma unroll
    for (int i = 0; i < 2; ++i) { int R, C; stage_rc(tid * 16 + i * 8192, R, C); const int Rb = Epi::PERM ? ((R & ~31) + perm32(R & 31)) : R;
        voffA[i] = (unsigned)(R * K + C) * 2u; voffB[i] = (unsigned)(Rb * K + C) * 2u; }
    const size_t kstep = (size_t)(BK * 2);
    const size_t hstep = (size_t)HALF * K * 2;
    const size_t tstep = 2 * hstep;
    const unsigned ldsw = (unsigned)wid * 1024u;
    const int aoff = lds_byte(wr * 64 + fr, fq * 8), boff = lds_byte(wc * 32 + fr, fq * 8);
#define PG8_SA(b, h) (((b) * 2 + (h)) * HTB)
#define PG8_SB(b, h) ((4 + (b) * 2 + (h)) * HTB)
#define PG8_STAGE(bufoff, gbase, voff) do { _Pragma("unroll") for (int _i = 0; _i < 2; ++_i) \
        __builtin_amdgcn_global_load_lds((const unsigned*)((const char*)(gbase) + (voff)[_i]), (PG8_LAS unsigned*)(lds + (bufoff) + ldsw + _i * 8192), 16, 0, 0); } while (0)
#define PG8_LDA(dst, b, h) do { _Pragma("unroll") for (int m = 0; m < 4; ++m) _Pragma("unroll") for (int k = 0; k < 2; ++k) dst[m][k] = *(const PG8_LAS bf16x8*)(lds + PG8_SA(b, h) + aoff + m * 2048 + k * 1024); } while (0)
#define PG8_LDB(dst, b, h) do { _Pragma("unroll") for (int n = 0; n < 2; ++n) _Pragma("unroll") for (int k = 0; k < 2; ++k) dst[n][k] = *(const PG8_LAS bf16x8*)(lds + PG8_SB(b, h) + boff + n * 2048 + k * 1024); } while (0)
#define PG8_MMA(ai, bj, At, Bt) do { __builtin_amdgcn_s_setprio(1); _Pragma("unroll") for (int m = 0; m < 4; ++m) _Pragma("unroll") for (int n = 0; n < 2; ++n) _Pragma("unroll") for (int k = 0; k < 2; ++k) \
        acc[ai][bj][m][n] = __builtin_amdgcn_mfma_f32_16x16x32_bf16(Bt[n][k], At[m][k], acc[ai][bj][m][n], 0, 0, 0); __builtin_amdgcn_s_setprio(0); } while (0)
#define PG8_WAIT_V(n) asm volatile("s_waitcnt vmcnt(" #n ")" ::: "memory")
#define PG8_WAIT_L(n) asm volatile("s_waitcnt lgkmcnt(" #n ")" ::: "memory")
#define PG8_BAR __builtin_amdgcn_s_barrier()
#define PG8_SCHED __builtin_amdgcn_sched_barrier(0)
    Unit cur, nxt; int ui = 0;
    if (!S.next(0, cur)) return;
    f32x4 acc[2][2][4][2];
#pragma unroll
    for (int a = 0; a < 2; ++a)
#pragma unroll
        for (int b = 0; b < 2; ++b)
#pragma unroll
            for (int m = 0; m < 4; ++m)
#pragma unroll
                for (int n = 0; n < 2; ++n) acc[a][b][m][n] = (f32x4){0.f, 0.f, 0.f, 0.f};
    bf16x8 At[4][2], B0[2][2], B1[2][2];
    const char* cA = (const char*)g.A + (size_t)cur.pm * tstep; const char* cB = (const char*)g.Bt + (size_t)cur.pn * tstep;
    S.a_ready(cur);
    if constexpr (SP2) {
        PG8_STAGE(PG8_SB(0, 0), cB, voffB); PG8_STAGE(PG8_SB(0, 1), cB + hstep, voffB); PG8_STAGE(PG8_SA(0, 0), cA, voffA); PG8_STAGE(PG8_SA(0, 1), cA + hstep, voffA);
        if (wr == 1) PG8_BAR;
        PG8_WAIT_V(2); PG8_BAR;
        PG8_STAGE(PG8_SB(1, 0), cB + kstep, voffB); PG8_STAGE(PG8_SA(1, 0), cA + kstep, voffA); PG8_STAGE(PG8_SB(1, 1), cB + hstep + kstep, voffB);
        PG8_WAIT_V(6); PG8_BAR;
    } else {
        PG8_STAGE(PG8_SB(0, 0), cB, voffB); PG8_STAGE(PG8_SA(0, 0), cA, voffA); PG8_STAGE(PG8_SB(0, 1), cB + hstep, voffB); PG8_STAGE(PG8_SA(0, 1), cA + hstep, voffA);
        if (wr == 1) PG8_BAR;
        PG8_WAIT_V(4); PG8_BAR;
        PG8_STAGE(PG8_SB(1, 0), cB + kstep, voffB); PG8_STAGE(PG8_SA(1, 0), cA + kstep, voffA); PG8_STAGE(PG8_SB(1, 1), cB + hstep + kstep, voffB);
        PG8_WAIT_V(6); PG8_BAR;
    }
    for (;;) {
        const bool has_next = S.next(ui + 1, nxt);
        const char* nA = has_next ? (const char*)g.A + (size_t)nxt.pm * tstep : cA; const char* nB = has_next ? (const char*)g.Bt + (size_t)nxt.pn * tstep : cB;
        for (int t = 0; t < nt; t += 2) {
            const bool last = (t == nt - 2);
            const char* a1 = cA + (size_t)(t + 1) * kstep;
            const char* a2 = last ? nA : cA + (size_t)(t + 2) * kstep; const char* b2 = last ? nB : cB + (size_t)(t + 2) * kstep;
            const char* a3 = a2 + kstep; const char* b3 = b2 + kstep;
            if (last && has_next) S.a_ready(nxt);
            if constexpr (SP2) {
            PG8_LDB(B0, 0, 0); PG8_LDB(B1, 0, 1); PG8_SCHED; PG8_LDA(At, 0, 0); PG8_STAGE(PG8_SA(1, 1), a1 + hstep, voffA);
            PG8_WAIT_V(8); PG8_WAIT_L(0); PG8_BAR; PG8_MMA(0, 0, At, B0); PG8_MMA(0, 1, At, B1); PG8_BAR; PG8_SCHED;
            PG8_LDA(At, 0, 1); PG8_STAGE(PG8_SB(0, 0), b2, voffB); PG8_STAGE(PG8_SB(0, 1), b2 + hstep, voffB); PG8_STAGE(PG8_SA(0, 0), a2, voffA);
            PG8_WAIT_V(8); PG8_WAIT_L(0); PG8_BAR; PG8_MMA(1, 0, At, B0); PG8_MMA(1, 1, At, B1); PG8_BAR; PG8_SCHED;
            PG8_LDB(B0, 1, 0); PG8_LDB(B1, 1, 1); PG8_SCHED; PG8_LDA(At, 1, 0); PG8_STAGE(PG8_SA(0, 1), a2 + hstep, voffA);
            PG8_WAIT_V(8); PG8_WAIT_L(0); PG8_BAR; PG8_MMA(0, 0, At, B0); PG8_MMA(0, 1, At, B1); PG8_BAR; PG8_SCHED;
            PG8_LDA(At, 1, 1); PG8_STAGE(PG8_SB(1, 0), b3, voffB); PG8_STAGE(PG8_SB(1, 1), b3 + hstep, voffB); PG8_STAGE(PG8_SA(1, 0), a3, voffA);
            PG8_WAIT_V(8); PG8_WAIT_L(0); PG8_BAR; PG8_MMA(1, 0, At, B0); PG8_MMA(1, 1, At, B1); PG8_BAR; PG8_SCHED;
            } else {
            PG8_LDB(B0, 0, 0); PG8_SCHED; PG8_LDA(At, 0, 0); PG8_STAGE(PG8_SA(1, 1), a1 + hstep, voffA);
            PG8_WAIT_L(8); PG8_BAR; PG8_WAIT_L(0); PG8_MMA(0, 0, At, B0); PG8_BAR; PG8_SCHED;
            PG8_LDB(B1, 0, 1); PG8_STAGE(PG8_SB(0, 0), b2, voffB);
            PG8_BAR; PG8_WAIT_L(0); PG8_MMA(0, 1, At, B1); PG8_BAR;
            PG8_LDA(At, 0, 1); PG8_STAGE(PG8_SA(0, 0), a2, voffA);
            PG8_BAR; PG8_WAIT_L(0); PG8_MMA(1, 0, At, B0); PG8_BAR; PG8_SCHED;
            PG8_STAGE(PG8_SB(0, 1), b2 + hstep, voffB);
            PG8_WAIT_V(6); PG8_BAR; PG8_MMA(1, 1, At, B1); PG8_BAR;
            PG8_LDB(B0, 1, 0); PG8_SCHED; PG8_LDA(At, 1, 0); PG8_STAGE(PG8_SA(0, 1), a2 + hstep, voffA);
            PG8_WAIT_L(8); PG8_BAR; PG8_WAIT_L(0); PG8_MMA(0, 0, At, B0); PG8_BAR; PG8_SCHED;
            PG8_LDB(B1, 1, 1); PG8_STAGE(PG8_SB(1, 0), b3, voffB);
            PG8_BAR; PG8_WAIT_L(0); PG8_MMA(0, 1, At, B1); PG8_BAR;
            PG8_LDA(At, 1, 1); PG8_STAGE(PG8_SA(1, 0), a3, voffA);
            PG8_BAR; PG8_WAIT_L(0); PG8_MMA(1, 0, At, B0); PG8_BAR; PG8_SCHED;
            PG8_STAGE(PG8_SB(1, 1), b3 + hstep, voffB);
            PG8_WAIT_V(6); PG8_BAR; PG8_MMA(1, 1, At, B1); PG8_BAR;
            }
        }
        if constexpr (ALIGN_EPI) { if (wr == 0) PG8_BAR; }
        E(acc, cur, wr, wc, fr, fq, epx, wid, lane); S.done(cur);
        if (!has_next) break;
#pragma unroll
        for (int a = 0; a < 2; ++a)
#pragma unroll
            for (int b = 0; b < 2; ++b)
#pragma unroll
                for (int m = 0; m < 4; ++m)
#pragma unroll
                    for (int n = 0; n < 2; ++n) acc[a][b][m][n] = (f32x4){0.f, 0.f, 0.f, 0.f};
        cur = nxt; cA = nA; cB = nB; ++ui;
        if constexpr (ALIGN_EPI) { if (wr == 1) PG8_BAR; }
    }
    PG8_WAIT_V(0);
    if constexpr (!ALIGN_EPI) { if (wr == 0) PG8_BAR; }
    PG8_BAR;
#undef PG8_SA
#undef PG8_SB
#undef PG8_STAGE
#undef PG8_LDA
#undef PG8_LDB
#undef PG8_MMA
#undef PG8_WAIT_V
#undef PG8_WAIT_L
#undef PG8_BAR
#undef PG8_SCHED
}
}
constexpr int NWAVES = 8;
constexpr int BATCH = 2, SEQ = 16384, D = 1024, M = BATCH * SEQ, NH = 8, DH = 128, LBLK = 256, NB = SEQ / LBLK, TOPK = 3, DFF = 2816, NIN = 7168, CKW = 31;
constexpr float LN_EPS = 1e-6f;
constexpr int N_PHASES = 9;
#ifndef MK_N_LAUNCHES
#define MK_N_LAUNCHES 1
#endif
constexpr int N_LAUNCHES = MK_N_LAUNCHES;
constexpr size_t MiB = 1u << 20;
constexpr size_t WS_CTL = 0, CTL_ZERO_BYTES = 1 * MiB;
constexpr size_t WS_W_IN = 2 * MiB, WS_W_CO = 16 * MiB, WS_W_AO = 18 * MiB, WS_W_O = 20 * MiB, WS_W_GU = 22 * MiB, WS_W_D = 33 * MiB;
constexpr size_t WS_KPART = 39 * MiB, WS_LPART = 40 * MiB, WS_SSQ = 43 * MiB, WS_SELMASK = 43 * MiB + 512 * 1024, WS_LISTS = 44 * MiB;
constexpr int LIST_PER_BH = 516096;
constexpr size_t WS_A1 = 60 * MiB, WS_A2 = 124 * MiB, WS_A3 = 188 * MiB, WS_A4 = 252 * MiB, WS_A5 = 316 * MiB, WS_A6 = 380 * MiB, WS_A7 = 444 * MiB, WS_END = 508 * MiB;
static_assert(WS_LISTS + (size_t)LIST_PER_BH * 16 * 2 <= WS_A1 && WS_W_D + (size_t)D * DFF * 2 <= WS_KPART && WS_W_GU + (size_t)2 * DFF * D * 2 <= WS_W_D, "ws map");
static_assert((size_t)M * DFF * 2 <= 3 * 64 * MiB, "act fits A3..A5");
constexpr int CW_TMO = 0, CW_CODE = 1, CW_BAR = 4096, CW_GCOUNT = 16384;
constexpr int RING_OFF = 0, RING_BYTES = 131072, EPX_OFF = RING_BYTES, EPX_BYTES = 8192;
constexpr int LDSCTL_OFF = EPX_OFF + EPX_BYTES, MISC_OFF = LDSCTL_OFF + 320;
constexpr int LDS_BYTES = 147456;
static_assert(MISC_OFF + 128 <= LDS_BYTES, "LDS map");
#define GAS __attribute__((address_space(1)))
#define LAS __attribute__((address_space(3)))
typedef unsigned short bf16;
typedef unsigned v4u __attribute__((ext_vector_type(4)));
typedef float f32x4 __attribute__((ext_vector_type(4)));
typedef short bf16x8 __attribute__((ext_vector_type(8)));
typedef GAS unsigned gu32;
typedef GAS unsigned long long gu64;
#define RLX_AGENT __ATOMIC_RELAXED, __HIP_MEMORY_SCOPE_AGENT
#define LDS_WAIT() asm volatile("s_waitcnt lgkmcnt(0)" ::: "memory")
#define VM_WAIT() asm volatile("s_waitcnt vmcnt(0)" ::: "memory")
__device__ __forceinline__ unsigned long long rt() { return __builtin_amdgcn_s_memrealtime(); }
__device__ __forceinline__ unsigned f2bf(float f) { unsigned u = __builtin_bit_cast(unsigned, f); return (u + 0x7fffu + ((u >> 16) & 1u)) >> 16; }
__device__ __forceinline__ unsigned pk2(float lo, float hi) { return f2bf(lo) | (f2bf(hi) << 16); }

#define XB_TMO      128
#define XB_XCNT(j)  (256  + 64 * (j))
#define XB_XSUB(j)  (1280 + 64 * (j))
#define XB_XGEN(j)  (2304 + 64 * (j))
#define XB_TOP      3328
#define XB_TOPGEN   3392
#define XCD_BAR_WORDS 3456
#define XB_SPIN_CAP (1u << 18)

__device__ __forceinline__ unsigned xb_ld(unsigned* p)              { return __hip_atomic_load(p, __ATOMIC_RELAXED, __HIP_MEMORY_SCOPE_AGENT); }
__device__ __forceinline__ unsigned xb_add(unsigned* p, unsigned v) { return __hip_atomic_fetch_add(p, v, __ATOMIC_RELAXED, __HIP_MEMORY_SCOPE_AGENT); }
__device__ __forceinline__ unsigned xb_xcc_id() { return (unsigned)__builtin_amdgcn_s_getreg((3 << 11) | 20) & 0xFu; }
#define XB_SPIN(cond, bar) do { unsigned _sp = 0; while (cond) { __builtin_amdgcn_s_sleep(1); \
    if ((++_sp & 255u) == 0u) { if (xb_ld(&(bar)[XB_TMO])) break; if (_sp > XB_SPIN_CAP) { atomicAdd(&(bar)[XB_TMO], 1u); break; } } } } while (0)

struct XcdBarrier {
    unsigned* bar; unsigned x;
    volatile LAS unsigned* st;
};

__device__ __forceinline__ XcdBarrier xcd_barrier_post(unsigned* bar, volatile LAS unsigned* st) {
    XcdBarrier b; b.bar = bar; b.x = xb_xcc_id(); b.st = st;
    if (threadIdx.x == 0) (void)xb_add(&bar[XB_XCNT(b.x)], 1u);
    return b;
}
__device__ __forceinline__ void xcd_barrier_complete(unsigned* bar, unsigned x, unsigned& nloc, unsigned& nx) {
    const unsigned G = gridDim.x * gridDim.y * gridDim.z;
    unsigned sum, cnt, mine, sp = 0u;
    for (;;) {
        sum = 0u; cnt = 0u; mine = 0u;
#pragma unroll
        for (unsigned j = 0; j < 16; ++j) { const unsigned c = xb_ld(&bar[XB_XCNT(j)]); sum += c; cnt += (c > 0u) ? 1u : 0u; mine = (j == x) ? c : mine; }
        if (sum == G) break;
        __builtin_amdgcn_s_sleep(1);
        if ((++sp & 255u) == 0u) { if (xb_ld(&bar[XB_TMO])) break; if (sp > XB_SPIN_CAP) { atomicAdd(&bar[XB_TMO], 1u); break; } }
    }
    nloc = mine > 0u ? mine : 1u; nx = cnt > 0u ? cnt : 1u;
}

__device__ __forceinline__ void xcd_barrier(const XcdBarrier& b) {
    asm volatile("s_waitcnt vmcnt(0)" ::: "memory");
    __syncthreads();
    if (threadIdx.x == 0) {
        unsigned* bar = b.bar;
        __builtin_amdgcn_s_waitcnt(0);
        unsigned nloc = b.st[0], nx = b.st[1];
        if (nloc == 0u) { xcd_barrier_complete(bar, b.x, nloc, nx); b.st[0] = nloc; b.st[1] = nx; }
        const unsigned old = xb_add(&bar[XB_XSUB(b.x)], 1u);
        const unsigned gen = old / nloc;
        if (old + 1u == (gen + 1u) * nloc) {
            __builtin_amdgcn_fence(__ATOMIC_RELEASE, "agent");
            asm volatile("s_waitcnt vmcnt(0)" ::: "memory");
            const unsigned og = xb_add(&bar[XB_TOP], 1u);
            const unsigned tg = og / nx;
            if (og + 1u == (tg + 1u) * nx) xb_add(&bar[XB_TOPGEN], 1u);
            else XB_SPIN(xb_ld(&bar[XB_TOPGEN]) == tg, bar);
            __builtin_amdgcn_fence(__ATOMIC_ACQUIRE, "agent");
            xb_add(&bar[XB_XGEN(b.x)], 1u);
            asm volatile("s_waitcnt vmcnt(0)" ::: "memory");
        } else {
            XB_SPIN(xb_ld(&bar[XB_XGEN(b.x)]) == gen, bar);
            __builtin_amdgcn_fence(__ATOMIC_ACQUIRE, "agent");
            asm volatile("s_waitcnt vmcnt(0)" ::: "memory");
        }
    }
    __syncthreads();
}
typedef unsigned u32x2 __attribute__((ext_vector_type(2)));
typedef float f32x2v __attribute__((ext_vector_type(2)));
typedef float f32x16 __attribute__((ext_vector_type(16)));
typedef short s16x4 __attribute__((ext_vector_type(4)));
struct Args { const float* in[16]; float* out; unsigned char* ws; int ph_lo, ph_hi, li, pad; };
enum { IN_X = 0, IN_N1G, IN_WIN, IN_DWW, IN_DWB, IN_CLNG, IN_CLNB, IN_WCO, IN_QNG, IN_KNG, IN_WAO, IN_WO, IN_N2G, IN_WFG, IN_WFU, IN_WFD };
struct Frame {
    LAS unsigned char* lds;
    volatile LAS unsigned* MISC;
    gu32* ctl;
    unsigned char* ws; float* out;
    int wave, vcu, G;
};
#define TID_ ((int)threadIdx.x)
#define LANE_ ((int)threadIdx.x & 63)
#define WSB(off) ((bf16*)(F.ws + (off)))
#define WSF(off) ((float*)(F.ws + (off)))
__device__ __forceinline__ float wave_sum(float v) {
#pragma unroll
    for (int o = 1; o < 64; o <<= 1) v += __shfl_xor(v, o);
    return v;
}
__device__ __forceinline__ float wave_max(float v) {
#pragma unroll
    for (int o = 1; o < 64; o <<= 1) v = fmaxf(v, __shfl_xor(v, o));
    return v;
}
__device__ __forceinline__ float bf_lo(unsigned u) { return __uint_as_float(u << 16); }
__device__ __forceinline__ float bf_hi(unsigned u) { return __uint_as_float(u & 0xffff0000u); }
__device__ __forceinline__ void p0_transpose_item(const float* W, int K, int N, bf16* WT, int k0, int n0, int drow0, LAS float* scr, int lane) {
#pragma unroll
    for (int i = 0; i < 32; ++i) { const int kk = 2 * i + (lane >> 5); scr[kk * 33 + (lane & 31)] = W[(size_t)(k0 + kk) * N + n0 + (lane & 31)]; }
    LDS_WAIT(); asm volatile("" ::: "memory");
    const int c = lane & 7;
#pragma unroll
    for (int j = 0; j < 4; ++j) { const int n = (lane >> 3) + 8 * j; const LAS float* s = scr + (8 * c) * 33 + n;
        v4u o; o.x = pk2(s[0 * 33], s[1 * 33]); o.y = pk2(s[2 * 33], s[3 * 33]); o.z = pk2(s[4 * 33], s[5 * 33]); o.w = pk2(s[6 * 33], s[7 * 33]);
        *(GAS v4u*)(WT + (size_t)(drow0 + n) * K + k0 + 8 * c) = o; }
    LDS_WAIT(); asm volatile("" ::: "memory");
}
__device__ __forceinline__ void rms_rows4_to_bf16(const float* xrow, const float* g, bf16* orow) {
    const GAS f32x4* gr = (const GAS f32x4*)g + LANE_;
    f32x4 v[4][4]; float s2[4];
#pragma unroll
    for (int r = 0; r < 4; ++r) { const GAS f32x4* xr = (const GAS f32x4*)(xrow + (size_t)r * D) + LANE_;
#pragma unroll
        for (int j = 0; j < 4; ++j) v[r][j] = xr[64 * j]; }
#pragma unroll
    for (int r = 0; r < 4; ++r) { float a = 0.f;
#pragma unroll
        for (int j = 0; j < 4; ++j) a += (v[r][j].x * v[r][j].x + v[r][j].y * v[r][j].y) + (v[r][j].z * v[r][j].z + v[r][j].w * v[r][j].w);
        s2[r] = a; }
#pragma unroll
    for (int o = 1; o < 64; o <<= 1) {
#pragma unroll
        for (int r = 0; r < 4; ++r) s2[r] += __shfl_xor(s2[r], o); }
    f32x4 gg[4];
#pragma unroll
    for (int j = 0; j < 4; ++j) gg[j] = gr[64 * j];
#pragma unroll
    for (int r = 0; r < 4; ++r) { const float rstd = 1.f / sqrtf(s2[r] * (1.f / D) + LN_EPS);
        GAS unsigned long long* o8 = (GAS unsigned long long*)(orow + (size_t)r * D) + LANE_;
#pragma unroll
        for (int j = 0; j < 4; ++j) o8[64 * j] = (unsigned long long)pk2(v[r][j].x * rstd * gg[j].x, v[r][j].y * rstd * gg[j].y) | ((unsigned long long)pk2(v[r][j].z * rstd * gg[j].z, v[r][j].w * rstd * gg[j].w) << 32); }
}
__device__ __forceinline__ void p0_prologue(Frame& F, const Args& A) {
    LAS float* scr = (LAS float*)(F.lds + RING_OFF + F.wave * 16384);
    const int gw = F.vcu * NWAVES + F.wave, NGW = F.G * NWAVES;
    constexpr int I_IN = (D / 64) * (NIN / 32), I_SQ = (D / 64) * (D / 32), I_GU = (D / 64) * (DFF / 32), I_DN = (DFF / 64) * (D / 32);
    for (int r = gw; r < I_IN; r += NGW) { const int nblk = NIN / 32, kb = r / nblk, n0 = 32 * (r % nblk); int drow;
        if (n0 < 2048) { const int isg = n0 >= 1024, c = n0 - 1024 * isg; drow = 256 * (c >> 7) + 128 * isg + (c & 127); } else drow = n0;
        p0_transpose_item(A.in[IN_WIN], D, NIN, WSB(WS_W_IN), 64 * kb, n0, drow, scr, LANE_); }
    for (int r = gw; r < I_SQ; r += NGW) { const int nblk = D / 32, kb = r / nblk, n0 = 32 * (r % nblk); p0_transpose_item(A.in[IN_WCO], D, D, WSB(WS_W_CO), 64 * kb, n0, n0, scr, LANE_); }
    for (int r = gw; r < I_SQ; r += NGW) { const int nblk = D / 32, kb = r / nblk, n0 = 32 * (r % nblk); p0_transpose_item(A.in[IN_WAO], D, D, WSB(WS_W_AO), 64 * kb, n0, n0, scr, LANE_); }
    for (int r = gw; r < I_SQ; r += NGW) { const int nblk = D / 32, kb = r / nblk, n0 = 32 * (r % nblk); p0_transpose_item(A.in[IN_WO], D, D, WSB(WS_W_O), 64 * kb, n0, n0, scr, LANE_); }
    for (int r = gw; r < I_GU; r += NGW) { const int nblk = DFF / 32, kb = r / nblk, n0 = 32 * (r % nblk); p0_transpose_item(A.in[IN_WFG], D, DFF, WSB(WS_W_GU), 64 * kb, n0, 256 * (n0 >> 7) + (n0 & 127), scr, LANE_); }
    for (int r = gw; r < I_GU; r += NGW) { const int nblk = DFF / 32, kb = r / nblk, n0 = 32 * (r % nblk); p0_transpose_item(A.in[IN_WFU], D, DFF, WSB(WS_W_GU), 64 * kb, n0, 256 * (n0 >> 7) + 128 + (n0 & 127), scr, LANE_); }
    for (int r = gw; r < I_DN; r += NGW) { const int nblk = D / 32, kb = r / nblk, n0 = 32 * (r % nblk); p0_transpose_item(A.in[IN_WFD], DFF, D, WSB(WS_W_D), 64 * kb, n0, n0, scr, LANE_); }
    for (int m = 4 * gw; m < M; m += 4 * NGW) rms_rows4_to_bf16(A.in[IN_X] + (size_t)m * D, A.in[IN_N1G], WSB(WS_A1) + (size_t)m * D);
}
__device__ __forceinline__ void conv_unit(Frame& F, const Args& A, int unit) {
    const int b = unit >> 9, t0 = (unit & 511) * 32, c0 = 2 * TID_;
    LAS float* ys = (LAS float*)(F.lds + RING_OFF);
    const bf16* ab = WSB(WS_A2) + (size_t)b * SEQ * D + c0;
    unsigned in[62];
#pragma unroll
    for (int i = 0; i < 62; ++i) { const int t = t0 - 30 + i; in[i] = (t >= 0) ? *(const GAS unsigned*)(ab + (size_t)t * D) : 0u; }
    float w0[CKW], w1[CKW];
#pragma unroll
    for (int j = 0; j < CKW; ++j) { const float2 w = *(const float2*)(A.in[IN_DWW] + j * D + c0); w0[j] = w.x; w1[j] = w.y; }
    const float2 bias = *(const float2*)(A.in[IN_DWB] + c0);
#pragma unroll
    for (int tt = 0; tt < 32; ++tt) {
        float y0 = bias.x, y1 = bias.y;
#pragma unroll
        for (int j = 0; j < CKW; ++j) { y0 = fmaf(w0[j], bf_lo(in[tt + j]), y0); y1 = fmaf(w1[j], bf_hi(in[tt + j]), y1); }
        *(LAS f32x2v*)(ys + tt * 1024 + c0) = (f32x2v){y0, y1};
    }
    LDS_WAIT(); __syncthreads();
#pragma unroll 1
    for (int q = 0; q < 4; ++q) {
        const int tt = F.wave * 4 + q; const LAS f32x4* yr = (const LAS f32x4*)(ys + tt * 1024) + LANE_;
        f32x4 v[4]; float s = 0.f;
#pragma unroll
        for (int j = 0; j < 4; ++j) { v[j] = yr[64 * j]; s += (v[j].x + v[j].y) + (v[j].z + v[j].w); }
        const float mean = wave_sum(s) * (1.f / D); float s2 = 0.f;
#pragma unroll
        for (int j = 0; j < 4; ++j) { v[j] = v[j] - mean; s2 += (v[j].x * v[j].x + v[j].y * v[j].y) + (v[j].z * v[j].z + v[j].w * v[j].w); }
        const float rstd = 1.f / sqrtf(wave_sum(s2) * (1.f / D) + LN_EPS);
        GAS unsigned long long* o8 = (GAS unsigned long long*)(WSB(WS_A1) + ((size_t)b * SEQ + t0 + tt) * D) + LANE_;
#pragma unroll
        for (int j = 0; j < 4; ++j) { const f32x4 gg = ((const GAS f32x4*)A.in[IN_CLNG])[64 * j + LANE_], bb = ((const GAS f32x4*)A.in[IN_CLNB])[64 * j + LANE_];
            f32x4 y = v[j] * rstd * gg + bb;
            y.x = y.x * pg8::sigm(y.x); y.y = y.y * pg8::sigm(y.y); y.z = y.z * pg8::sigm(y.z); y.w = y.w * pg8::sigm(y.w);
            o8[64 * j] = (unsigned long long)pk2(y.x, y.y) | ((unsigned long long)pk2(y.z, y.w) << 32); }
    }
    __syncthreads();
}
__device__ __forceinline__ int crow(int r, int hi) { return (r & 3) + 8 * (r >> 2) + 4 * hi; }
__device__ __forceinline__ int list_off(int j) { return 16384 * j - 128 * j * (j + 1); }
#define TOP_INS(val, idx) do { const float v_ = (val); const int i_ = (idx); \
    if (v_ > v1 || (v_ == v1 && i_ < i1)) { v3 = v2; i3 = i2; v2 = v1; i2 = i1; v1 = v_; i1 = i_; } \
    else if (v_ > v2 || (v_ == v2 && i_ < i2)) { v3 = v2; i3 = i2; v2 = v_; i2 = i_; } \
    else if (v_ > v3 || (v_ == v3 && i_ < i3)) { v3 = v_; i3 = i_; } } while (0)
__device__ __forceinline__ void route_unit(Frame& F, int b, int h, int cur) {
    const int lane = LANE_, r32 = lane & 31, hi = lane >> 5, wid = F.wave, bh = b * NH + h;
    LAS unsigned char* kmimg = F.lds + RING_OFF; LAS unsigned* cnt = (LAS unsigned*)(F.lds + RING_OFF + 16384); LAS unsigned* base = cnt + 64;
    if (TID_ < 64) cnt[TID_] = 0u;
    {
        const int row = TID_ >> 3, c2 = (TID_ & 7) * 2; const float* kp = WSF(WS_KPART) + ((size_t)(bh * NB + row) * 2) * DH + c2 * 8;
#pragma unroll
        for (int cc = 0; cc < 2; ++cc) {
            const f32x4 a0 = *(const GAS f32x4*)(kp + 8 * cc), a1 = *(const GAS f32x4*)(kp + 8 * cc + 4), b0 = *(const GAS f32x4*)(kp + DH + 8 * cc), b1 = *(const GAS f32x4*)(kp + DH + 8 * cc + 4);
            const f32x4 m0 = (a0 + b0) * (1.0f / 256.0f), m1 = (a1 + b1) * (1.0f / 256.0f);
            const v4u w = (v4u){pk2(m0.x, m0.y), pk2(m0.z, m0.w), pk2(m1.x, m1.y), pk2(m1.z, m1.w)};
            *(LAS v4u*)(kmimg + 256 * row + 16 * ((c2 + cc) ^ (((row & 3) << 2) | ((row >> 2) & 3)))) = w; }
    }
    const int t = cur * LBLK + wid * 32 + r32;
    const bf16* qp = WSB(WS_A3) + ((size_t)b * SEQ + t) * D + h * DH + hi * 8;
    bf16x8 qf[8];
#pragma unroll
    for (int d0 = 0; d0 < 8; ++d0) qf[d0] = *(const GAS bf16x8*)(qp + 16 * d0);
    float v1 = -INFINITY, v2 = -INFINITY, v3 = -INFINITY; int i1 = 1 << 20, i2 = 1 << 20, i3 = 1 << 20;
    const int ng = (cur + 31) >> 5;
    const int kx = ((r32 & 3) << 2) | ((r32 >> 2) & 3);
    LDS_WAIT(); __syncthreads();
#pragma unroll 1
    for (int g = 0; g < ng; ++g) {
        f32x16 s;
#pragma unroll
        for (int r = 0; r < 16; ++r) s[r] = 0.f;
        const LAS unsigned char* kg = kmimg + 256 * (32 * g + r32);
#pragma unroll
        for (int d0 = 0; d0 < 8; ++d0) { const bf16x8 kf = *(const LAS bf16x8*)(kg + 16 * ((2 * d0 + hi) ^ kx)); s = __builtin_amdgcn_mfma_f32_32x32x16_bf16(kf, qf[d0], s, 0, 0, 0); }
#pragma unroll
        for (int r = 0; r < 16; ++r) { const int jj = 32 * g + crow(r, hi); const float val = (jj < cur) ? s[r] : -INFINITY; TOP_INS(val, jj); }
    }
    {
        const float p1 = __shfl_xor(v1, 32), p2 = __shfl_xor(v2, 32), p3 = __shfl_xor(v3, 32); const int j1 = __shfl_xor(i1, 32), j2 = __shfl_xor(i2, 32), j3 = __shfl_xor(i3, 32);
        TOP_INS(p1, j1); TOP_INS(p2, j2); TOP_INS(p3, j3);
    }
    const int nsel = cur < TOPK ? cur : TOPK;
    const float slope2 = __builtin_amdgcn_exp2f(-(float)(h + 1)) * 1.4426950408889634f;
    const bool k0 = slope2 * (float)(LBLK * (cur - i1) - 255) < 200.f, k1 = nsel > 1 && slope2 * (float)(LBLK * (cur - i2) - 255) < 200.f, k2 = nsel > 2 && slope2 * (float)(LBLK * (cur - i3) - 255) < 200.f;
    unsigned pos0 = 0, pos1 = 0, pos2 = 0;
    if (hi == 0) { if (k0) pos0 = __hip_atomic_fetch_add(cnt + i1, 1u, __ATOMIC_RELAXED, __HIP_MEMORY_SCOPE_WORKGROUP);
        if (k1) pos1 = __hip_atomic_fetch_add(cnt + i2, 1u, __ATOMIC_RELAXED, __HIP_MEMORY_SCOPE_WORKGROUP);
        if (k2) pos2 = __hip_atomic_fetch_add(cnt + i3, 1u, __ATOMIC_RELAXED, __HIP_MEMORY_SCOPE_WORKGROUP);
        (F.ws + WS_SELMASK)[((size_t)b * SEQ + t) * NH + h] = (unsigned char)((k0 ? 1 : 0) | (k1 ? 2 : 0) | (k2 ? 4 : 0)); }
    LDS_WAIT(); __syncthreads();
    if (TID_ < 64) { const unsigned c = cnt[TID_]; if (c) base[TID_] = __hip_atomic_fetch_add((unsigned*)(F.ctl + CW_GCOUNT + bh * NB + TID_), c, __ATOMIC_RELAXED, __HIP_MEMORY_SCOPE_AGENT); }
    LDS_WAIT(); __syncthreads();
    if (hi == 0) { unsigned short* L = (unsigned short*)(F.ws + WS_LISTS) + (size_t)bh * LIST_PER_BH;
        if (k0) L[list_off(i1) + base[i1] + pos0] = (unsigned short)((t << 2) | 0);
        if (k1) L[list_off(i2) + base[i2] + pos1] = (unsigned short)((t << 2) | 1);
        if (k2) L[list_off(i3) + base[i3] + pos2] = (unsigned short)((t << 2) | 2); }
    LDS_WAIT(); __syncthreads();
}
__device__ __forceinline__ bf16* opart_ptr(Frame& F, int slot) { return slot == 0 ? WSB(WS_A2) : ((bf16*)F.out + (size_t)(slot - 1) * M * D); }
#ifdef MK_PROBE_SEC
#define AT_STAMP(sec) do { if (OWN == (MK_PROBE_OWN != 0) && blockIdx.x == MK_PROBE_BLK && wid == 7 && lane == 0) { const unsigned long long n_ = __builtin_amdgcn_s_memrealtime(); F.MISC[16 + (sec)] += (unsigned)(n_ - at_last); at_last = n_; } } while (0)
#define AT_BEGIN() unsigned long long at_last = __builtin_amdgcn_s_memrealtime()
#else
#define AT_STAMP(sec) do {} while (0)
#define AT_BEGIN() do {} while (0)
#endif
template <bool OWN>
__device__ __forceinline__ void attn_unit(Frame& F, int b, int h, int j, int nrows, const unsigned short* list, int nsel, float M2) {
    const int lane = LANE_, r32 = lane & 31, hi = lane >> 5, wid = F.wave;
    LAS unsigned char* Kimg = F.lds + RING_OFF; LAS unsigned char* Vimg = F.lds + RING_OFF + 65536;
    AT_BEGIN();
    {
        const bf16* Kg = WSB(WS_A4) + ((size_t)b * SEQ + (size_t)j * LBLK) * D + h * DH; const bf16* Vg = WSB(WS_A5) + ((size_t)b * SEQ + (size_t)j * LBLK) * D + h * DH;
#pragma unroll
        for (int i = 0; i < 8; ++i) {
            const int piece = wid * 8 + i, row = piece * 4 + (lane >> 4), ch = (lane & 15) ^ (((row & 3) << 2) | ((row >> 2) & 3));
            __builtin_amdgcn_global_load_lds((const unsigned*)(Kg + (size_t)row * D + ch * 8), (LAS unsigned*)(Kimg + piece * 1024), 16, 0, 0);
            __builtin_amdgcn_global_load_lds((const unsigned*)(Vg + (size_t)row * D + ch * 8), (LAS unsigned*)(Vimg + piece * 1024), 16, 0, 0);
        }
    }
    const int li = wid * 32 + r32; const bool valid = li < nrows; const bool wave_on = wid * 32 < nrows;
    int tq, slot = 0;
    if (OWN) tq = j * LBLK + li; else { const unsigned e = list[valid ? li : 0]; tq = (int)(e >> 2); slot = (int)(e & 3u); }
    const size_t qrow = (size_t)b * SEQ + tq;
    unsigned msk = 0u; if (OWN && nsel > 0) msk = (F.ws + WS_SELMASK)[qrow * NH + h];
    bf16x8 qf[8];
    { const bf16* qp = WSB(WS_A3) + qrow * D + h * DH + hi * 8;
#pragma unroll
      for (int d0 = 0; d0 < 8; ++d0) qf[d0] = *(const GAS bf16x8*)(qp + 16 * d0); }
    const float slope2 = __builtin_amdgcn_exp2f(-(float)(h + 1)) * 1.4426950408889634f;
    f32x16 o[4];
#pragma unroll
    for (int c = 0; c < 4; ++c)
#pragma unroll
        for (int r = 0; r < 16; ++r) o[c][r] = 0.f;
    float lsum = 0.f;
    VM_WAIT(); __syncthreads();
    AT_STAMP(0);
    if (wave_on) {
        const int kx = ((r32 & 3) << 2) | ((r32 >> 2) & 3);
        const LAS unsigned char* kbase = Kimg + 256 * r32;
        const LAS unsigned char* kad[8];
#pragma unroll
        for (int d0 = 0; d0 < 8; ++d0) kad[d0] = kbase + 16 * ((2 * d0 + hi) ^ kx);
        const int qq = (lane & 15) >> 2, pp = lane & 3, blk = (lane >> 4) & 1;
        const LAS unsigned char* vbase = Vimg + 256 * (4 * hi + qq) + 8 * (pp & 1);
        const LAS unsigned char* vad[4][2];
#pragma unroll
        for (int c = 0; c < 4; ++c)
#pragma unroll
            for (int t = 0; t < 2; ++t) vad[c][t] = vbase + 16 * (4 * (c ^ qq) + ((2 * blk + (pp >> 1)) ^ (2 * t + hi))) + 2048 * t;
        const int ng = OWN ? (wid + 1) : 8;
        const float bq = slope2 * (float)(j * LBLK + 4 * hi - tq) - M2;
#pragma unroll
        for (int g = 0; g < 8; ++g) {
            if (g < ng) {
                const float bg = bq + slope2 * (float)(32 * g);
                f32x16 s;
#pragma unroll
                for (int r = 0; r < 16; ++r) s[r] = fmaf(slope2, (float)((r & 3) + 8 * (r >> 2)), bg);
                if (OWN) { if (g == wid) {
#pragma unroll
                    for (int r = 0; r < 16; ++r) s[r] = (4 * hi + (r & 3) + 8 * (r >> 2) > r32) ? -INFINITY : s[r]; } }
#pragma unroll
                for (int d0 = 0; d0 < 8; ++d0) { const bf16x8 kf = *(const LAS bf16x8*)(kad[d0] + 8192 * g); s = __builtin_amdgcn_mfma_f32_32x32x16_bf16(kf, qf[d0], s, 0, 0, 0); }
                float p[16];
#pragma unroll
                for (int r = 0; r < 16; ++r) { p[r] = __builtin_amdgcn_exp2f(s[r]); lsum += p[r]; }
                v4u pk0, pk1;
                pk0.x = pg8::cvt_pk_bf16(p[0], p[1]); pk0.y = pg8::cvt_pk_bf16(p[2], p[3]); pk0.z = pg8::cvt_pk_bf16(p[4], p[5]); pk0.w = pg8::cvt_pk_bf16(p[6], p[7]);
                pk1.x = pg8::cvt_pk_bf16(p[8], p[9]); pk1.y = pg8::cvt_pk_bf16(p[10], p[11]); pk1.z = pg8::cvt_pk_bf16(p[12], p[13]); pk1.w = pg8::cvt_pk_bf16(p[14], p[15]);
                const bf16x8 pb0 = __builtin_bit_cast(bf16x8, pk0), pb1 = __builtin_bit_cast(bf16x8, pk1);
#pragma unroll
                for (int c = 0; c < 4; ++c) {
#pragma unroll
                    for (int s2 = 0; s2 < 2; ++s2) {
                        const s16x4 lo = __builtin_bit_cast(s16x4, __builtin_amdgcn_ds_read_tr16_b64_v4i16((LAS s16x4*)(vad[c][0] + 8192 * g + 4096 * s2)));
                        const s16x4 hh = __builtin_bit_cast(s16x4, __builtin_amdgcn_ds_read_tr16_b64_v4i16((LAS s16x4*)(vad[c][1] + 8192 * g + 4096 * s2)));
                        const bf16x8 vf = (bf16x8){lo[0], lo[1], lo[2], lo[3], hh[0], hh[1], hh[2], hh[3]};
                        o[c] = __builtin_amdgcn_mfma_f32_32x32x16_bf16(vf, s2 == 0 ? pb0 : pb1, o[c], 0, 0, 0);
                    }
                }
            }
        }
        lsum += __shfl_xor(lsum, 32);
    }
    AT_STAMP(1);
    const int c16 = lane & 15;
    v4u pw[8][3];
    if (OWN) {
#pragma unroll
        for (int it = 0; it < 4; ++it) { const int row = 4 * it + (lane >> 4); const size_t eoff = ((size_t)b * SEQ + j * LBLK + wid * 32 + row) * D + h * DH + 8 * c16;
            const unsigned mr = (unsigned)__shfl((int)msk, row);
#pragma unroll
            for (int sl = 0; sl < 3; ++sl) { pw[it][sl] = (v4u){0u, 0u, 0u, 0u}; if ((mr >> sl) & 1u) pw[it][sl] = *(const GAS v4u*)(opart_ptr(F, sl) + eoff); } }
    }
    LDS_WAIT(); __syncthreads(); AT_STAMP(2);
    if (wave_on) {
        LAS unsigned char* Sg = F.lds + RING_OFF + wid * 16384;
#pragma unroll
        for (int c = 0; c < 4; ++c)
#pragma unroll
            for (int gq = 0; gq < 4; ++gq) *(LAS f32x4*)(Sg + r32 * 512 + 16 * ((8 * c + 2 * gq + hi) ^ (r32 & 7))) = (f32x4){o[c][4 * gq], o[c][4 * gq + 1], o[c][4 * gq + 2], o[c][4 * gq + 3]};
        if (OWN) {
#pragma unroll
            for (int it = 4; it < 8; ++it) { const int row = 4 * it + (lane >> 4); const size_t eoff = ((size_t)b * SEQ + j * LBLK + wid * 32 + row) * D + h * DH + 8 * c16;
                const unsigned mr = (unsigned)__shfl((int)msk, row);
#pragma unroll
                for (int sl = 0; sl < 3; ++sl) { pw[it][sl] = (v4u){0u, 0u, 0u, 0u}; if ((mr >> sl) & 1u) pw[it][sl] = *(const GAS v4u*)(opart_ptr(F, sl) + eoff); } }
        }
        float ltot = lsum;
        if (OWN) { for (int sl = 0; sl < 3; ++sl) if ((msk >> sl) & 1u) ltot += WSF(WS_LPART)[((size_t)sl * M + qrow) * NH + h]; }
        else if (valid && hi == 0) WSF(WS_LPART)[((size_t)slot * M + qrow) * NH + h] = lsum;
        LDS_WAIT();
#pragma unroll
        for (int it = 0; it < 8; ++it) {
            const int row = 4 * it + (lane >> 4);
            f32x4 f0 = *(const LAS f32x4*)(Sg + row * 512 + 16 * ((2 * c16) ^ (row & 7))), f1 = *(const LAS f32x4*)(Sg + row * 512 + 16 * ((2 * c16 + 1) ^ (row & 7)));
            if (OWN) {
                const size_t eoff = ((size_t)b * SEQ + j * LBLK + wid * 32 + row) * D + h * DH + 8 * c16;
                const float rl = 1.0f / __shfl(ltot, row);
#pragma unroll
                for (int sl = 0; sl < 3; ++sl) { f32x4 a0, a1; pg8::unpack8(pw[it][sl], a0, a1); f0 += a0; f1 += a1; }
                *(GAS v4u*)(WSB(WS_A3) + eoff) = pg8::pack8(f0 * rl, f1 * rl);
            } else {
                const int tq_r = __shfl(tq, row), slot_r = __shfl(slot, row);
                const size_t eoff = ((size_t)b * SEQ + tq_r) * D + h * DH + 8 * c16;
                if (wid * 32 + row < nrows) *(GAS v4u*)(opart_ptr(F, slot_r) + eoff) = pg8::pack8(f0, f1);
            }
        }
    }
    AT_STAMP(3);
    LDS_WAIT(); __syncthreads();
}
__global__ void __launch_bounds__(NWAVES * 64, 2) mk_fwd(Args args) {
    extern __shared__ __attribute__((aligned(16))) unsigned char lds[];
    Frame F;
    F.lds = (LAS unsigned char*)lds;
    F.MISC = (volatile LAS unsigned*)(F.lds + MISC_OFF);
    F.wave = __builtin_amdgcn_readfirstlane(TID_ >> 6);
    F.G = gridDim.x; { const int bx = blockIdx.x; F.vcu = (F.G % 8 == 0) ? (bx % 8) * (F.G / 8) + bx / 8 : bx; }
    F.ws = args.ws; F.out = args.out;
    F.ctl = (gu32*)(F.ws + WS_CTL);
    const Args& A = args;
    for (int u = TID_; u < (LDS_BYTES - LDSCTL_OFF) / 4; u += NWAVES * 64) ((LAS unsigned*)(F.lds + LDSCTL_OFF))[u] = 0u;
    __syncthreads();
    XcdBarrier bar; bar.bar = (unsigned*)(F.ctl + CW_BAR); bar.x = 0; bar.st = nullptr;
    if (N_LAUNCHES == 1) bar = xcd_barrier_post((unsigned*)(F.ctl + CW_BAR), F.MISC + 8);
#define GRID_BAR() do { if (N_LAUNCHES == 1) xcd_barrier(bar); } while (0)
    const int lo = args.ph_lo, hi_ph = args.ph_hi;
#ifdef MK_PH
#define IN(k) ((k) == MK_PH)
#else
#define IN(k) (lo <= (k) && (k) < hi_ph)
#endif
#define BOTH(k) (IN(k) && IN((k) + 1))
    LAS float* epx = (LAS float*)(F.lds + EPX_OFF);
#ifdef MK_PROBE_PH
    unsigned long long pr_t0 = 0, pr_dt = 0;
#define PROBE_BEGIN(k) do { if ((k) == MK_PROBE_PH) pr_t0 = __builtin_amdgcn_s_memrealtime(); } while (0)
#define PROBE_END(k) do { if ((k) == MK_PROBE_PH) pr_dt = __builtin_amdgcn_s_memrealtime() - pr_t0; } while (0)
#else
#define PROBE_BEGIN(k) do {} while (0)
#define PROBE_END(k) do {} while (0)
#endif

    if (IN(0)) { PROBE_BEGIN(0); p0_prologue(F, A); if (BOTH(0)) GRID_BAR(); PROBE_END(0); }

    if (IN(1)) { PROBE_BEGIN(1);
        pg8::Gemm g{WSB(WS_A1), WSB(WS_W_IN), M, NIN, D}; pg8::StaticOrder S; S.init(M, NIN, F.G, (int)blockIdx.x);
        pg8::EpiInProj E{WSB(WS_A2), WSB(WS_A3), WSB(WS_A5), WSF(WS_KPART), A.in[IN_QNG], A.in[IN_KNG]};
        pg8::gemm_phase<pg8::EpiInProj, pg8::StaticOrder, true, true>(F.lds + RING_OFF, epx, g, S, E);
        if (BOTH(1)) GRID_BAR();
        PROBE_END(1);
    }
    if (IN(2)) { PROBE_BEGIN(2);
        PROBE_BEGIN(20);
        for (int u = F.vcu; u < BATCH * NH * (NB - 1); u += F.G) { const int bh = u / (NB - 1), cur = 1 + u % (NB - 1); route_unit(F, bh >> 3, bh & 7, cur); }
        PROBE_END(20); PROBE_BEGIN(21);
        for (int u = F.vcu; u < M / 32; u += F.G) conv_unit(F, A, u);
        PROBE_END(21);
        if (BOTH(2)) GRID_BAR();
        PROBE_END(2);
    }
    float M2;
    { const float a = fmaxf(fabsf(A.in[IN_QNG][LANE_]), fabsf(A.in[IN_QNG][64 + LANE_])), c = fmaxf(fabsf(A.in[IN_KNG][LANE_]), fabsf(A.in[IN_KNG][64 + LANE_]));
      M2 = wave_max(a) * wave_max(c) * (11.313708498984761f * 1.4426950408889634f * 1.01f); }
    if (IN(3)) { PROBE_BEGIN(3);
        {
            pg8::Gemm g{WSB(WS_A1), WSB(WS_W_CO), M, D, D}; pg8::StaticOrder S; S.init(M, D, F.G, (int)blockIdx.x);
            pg8::EpiGateMul E{WSB(WS_A6)};
            pg8::gemm_phase<pg8::EpiGateMul, pg8::StaticOrder, true, true>(F.lds + RING_OFF, epx, g, S, E);
        }
        LAS unsigned* pre = (LAS unsigned*)epx;
        {
            const unsigned n0 = __hip_atomic_load(F.ctl + CW_GCOUNT + 2 * TID_, RLX_AGENT), n1 = __hip_atomic_load(F.ctl + CW_GCOUNT + 2 * TID_ + 1, RLX_AGENT);
            const unsigned u0 = (n0 + 255u) >> 8, u1 = (n1 + 255u) >> 8; unsigned s = u0 + u1;
#pragma unroll
            for (int o = 1; o < 64; o <<= 1) { const unsigned t = __shfl_up(s, o); if (LANE_ >= o) s += t; }
            LAS unsigned* wt = pre + 1032;
            if (LANE_ == 63) wt[F.wave] = s;
            LDS_WAIT(); __syncthreads();
            unsigned wb = 0; for (int w = 0; w < F.wave; ++w) wb += wt[w];
            const unsigned excl = wb + s - (u0 + u1);
            pre[2 * TID_] = excl; pre[2 * TID_ + 1] = excl + u0;
            if (TID_ == NWAVES * 64 - 1) pre[1024] = excl + u0 + u1;
            LDS_WAIT(); __syncthreads();
        }
        const int total = (int)pre[1024];
        for (int u = F.vcu; u < total; u += F.G) {
            int lo_ = 0, hi_ = 1023;
            while (lo_ < hi_) { const int mid = (lo_ + hi_ + 1) >> 1; if ((int)pre[mid] <= u) lo_ = mid; else hi_ = mid - 1; }
            const int L = lo_, ui = u - (int)pre[L], bh = L >> 6, j = L & 63;
            const int n = (int)__hip_atomic_load(F.ctl + CW_GCOUNT + L, RLX_AGENT); const int nrows = (n - ui * 256) < 256 ? (n - ui * 256) : 256;
            attn_unit<false>(F, bh >> 3, bh & 7, j, nrows, (const unsigned short*)(F.ws + WS_LISTS) + (size_t)bh * LIST_PER_BH + list_off(j) + ui * 256, 0, M2);
        }
        __syncthreads();
        if (BOTH(3)) GRID_BAR();
        PROBE_END(3);
    }
    if (IN(4)) { PROBE_BEGIN(4);
        for (int u = F.vcu; u < BATCH * NH * NB; u += F.G) { const int bh = u >> 6, j = u & 63; attn_unit<true>(F, bh >> 3, bh & 7, j, 256, nullptr, j < TOPK ? j : TOPK, M2); }
        if (BOTH(4)) GRID_BAR();
        PROBE_END(4);
    }
    if (IN(5)) { PROBE_BEGIN(5);
        pg8::Gemm g{WSB(WS_A3), WSB(WS_W_AO), M, D, D}; pg8::StaticOrder S; S.init(M, D, F.G, (int)blockIdx.x);
        pg8::EpiMerge E{WSB(WS_A6), WSB(WS_A7), WSB(WS_A1)};
        pg8::gemm_phase<pg8::EpiMerge, pg8::StaticOrder, true, true>(F.lds + RING_OFF, epx, g, S, E);
        if (BOTH(5)) GRID_BAR();
        PROBE_END(5);
    }
    if (IN(6)) { PROBE_BEGIN(6);
        pg8::Gemm g{WSB(WS_A1), WSB(WS_W_O), M, D, D}; pg8::StaticOrder S; S.init(M, D, F.G, (int)blockIdx.x);
        pg8::EpiResNorm E{A.in[IN_X], F.out, WSB(WS_A2), A.in[IN_N2G], WSF(WS_SSQ)};
        pg8::gemm_phase<pg8::EpiResNorm, pg8::StaticOrder, true, true>(F.lds + RING_OFF, epx, g, S, E);
        if (BOTH(6)) GRID_BAR();
        PROBE_END(6);
    }
    if (IN(7)) { PROBE_BEGIN(7);
        pg8::Gemm g{WSB(WS_A2), WSB(WS_W_GU), M, 2 * DFF, D}; pg8::StaticOrder S; S.init(M, 2 * DFF, F.G, (int)blockIdx.x);
        pg8::EpiSwiGLU E{WSF(WS_SSQ), WSB(WS_A3), DFF};
        pg8::gemm_phase<pg8::EpiSwiGLU, pg8::StaticOrder, true, true>(F.lds + RING_OFF, epx, g, S, E);
        if (BOTH(7)) GRID_BAR();
        PROBE_END(7);
    }
    if (IN(8)) { PROBE_BEGIN(8);
        pg8::Gemm g{WSB(WS_A3), WSB(WS_W_D), M, D, DFF}; pg8::StaticOrder S; S.init(M, D, F.G, (int)blockIdx.x);
        pg8::EpiResOut E{F.out};
        pg8::gemm_phase<pg8::EpiResOut, pg8::StaticOrder, true, true>(F.lds + RING_OFF, epx, g, S, E);
        PROBE_END(8);
    }
#ifdef MK_PROBE_SEC
    __syncthreads();
    if (blockIdx.x == MK_PROBE_BLK && TID_ == 0) { const unsigned long long t1 = __builtin_amdgcn_s_memrealtime(); const unsigned long long dt = F.MISC[16 + MK_PROBE_SEC]; while (__builtin_amdgcn_s_memrealtime() - t1 < 4ull * dt) __builtin_amdgcn_s_sleep(8); }
#endif
#ifdef MK_PROBE_PH
    if (blockIdx.x == 0 && TID_ == 0) { const unsigned long long t1 = __builtin_amdgcn_s_memrealtime(); while (__builtin_amdgcn_s_memrealtime() - t1 < 4ull * pr_dt) __builtin_amdgcn_s_sleep(8); }
#endif
#undef IN
#undef BOTH
}

extern "C" void kernel_launch(void* const* d_in, const int* in_sizes, int n_in, void* d_out, int out_size, void* d_ws, size_t ws_size, hipStream_t stream) {
    static int grid = 0;
    if (grid == 0) {
        if (n_in != 16 || in_sizes[0] != M * D || out_size != M * D || ws_size < WS_END) { fprintf(stderr, "kernel_launch: unexpected shapes / workspace (n_in %d, in0 %d, out %d, ws %zu); nothing launched\n", n_in, n_in > 0 ? in_sizes[0] : -1, out_size, ws_size); grid = -1; return; }
        int dev = 0, cus = 0;
        if (hipGetDevice(&dev) != hipSuccess || hipDeviceGetAttribute(&cus, hipDeviceAttributeMultiprocessorCount, dev) != hipSuccess) { grid = -1; return; }
        if (hipFuncSetAttribute((const void*)mk_fwd, hipFuncAttributeMaxDynamicSharedMemorySize, LDS_BYTES) != hipSuccess) { fprintf(stderr, "kernel_launch: hipFuncSetAttribute failed\n"); grid = -1; return; }
        int per_cu = 0;
        if (hipOccupancyMaxActiveBlocksPerMultiprocessor(&per_cu, (const void*)mk_fwd, NWAVES * 64, LDS_BYTES) != hipSuccess || per_cu < 1) fprintf(stderr, "kernel_launch: occupancy query reports %d\n", per_cu);
        (void)hipGetLastError();
        grid = cus;
    }
    if (grid < 0) return;
    if (hipMemsetAsync((char*)d_ws + WS_CTL, 0, CTL_ZERO_BYTES, stream) != hipSuccess) return;
    Args a{};
    for (int i = 0; i < 16; ++i) a.in[i] = (const float*)d_in[i];
    a.out = (float*)d_out; a.ws = (unsigned char*)d_ws;
    for (int li = 0; li < N_LAUNCHES; ++li) {
        a.ph_lo = (N_LAUNCHES == 1) ? 0 : li; a.ph_hi = (N_LAUNCHES == 1) ? N_PHASES : li + 1; a.li = li;
        hipLaunchKernelGGL(mk_fwd, dim3(grid), dim3(NWAVES * 64), LDS_BYTES, stream, a);
    }
}
```
